# Optimizing an MI355X kernel written in HIP

```python
import math
import jax, jax.numpy as jnp
from jax import lax
import numpy as np

D_MODEL = 2048
BATCH = 4
SEQ = 2048
DEPTH = 1

N_META = 16
MLA_HEADS = 8
QK_NOPE_DIM = 128
QK_ROPE_DIM = 64
QK_HEAD_DIM = QK_NOPE_DIM + QK_ROPE_DIM
V_HEAD_DIM = 128
Q_LORA_RANK = 768
KV_LORA_RANK = 512
ROPE_THETA = 10000.0
Q_BLOCK = 128
MLA_WIDTH = MLA_HEADS * V_HEAD_DIM
CONV_CHANNELS = D_MODEL // 2
CONV_WIDTH = 31
MIX_WIDTH = MLA_WIDTH + CONV_CHANNELS
IN_PROJ_WIDTH = Q_LORA_RANK + KV_LORA_RANK + QK_ROPE_DIM + 2 * CONV_CHANNELS
N_EXPERTS = 32
TOP_K = 4
D_FF = D_MODEL
SWIGLU_LIMIT = 7.0
SWIGLU_ALPHA = 1.702
EXPERT_BLOCK = 128
DEEPNORM_ALPHA = (2.0 * DEPTH) ** 0.25
DEEPNORM_BETA = (8.0 * DEPTH) ** -0.25
LN_EPS = 1e-5
RMS_EPS = 1e-6

kernel_name = "hymba_mla_conformer_moe_deepnorm"


def layer_norm(x, g, b):
    xf = x.astype(jnp.float32)
    mu = jnp.mean(xf, axis=-1, keepdims=True)
    var = jnp.mean(jnp.square(xf - mu), axis=-1, keepdims=True)
    return ((xf - mu) * lax.rsqrt(var + LN_EPS)).astype(x.dtype) * g + b


def rms_norm(x, g):
    xf = x.astype(jnp.float32)
    ms = jnp.mean(jnp.square(xf), axis=-1, keepdims=True)
    return (xf * lax.rsqrt(ms + RMS_EPS)).astype(x.dtype) * g


def rope_tables(length, dtype):
    inv_freq = 1.0 / (ROPE_THETA ** (jnp.arange(0, QK_ROPE_DIM, 2, dtype=jnp.float32) / QK_ROPE_DIM))
    pos = jnp.arange(length, dtype=jnp.float32)
    freqs = pos[:, None] * inv_freq[None, :]
    emb = jnp.concatenate([freqs, freqs], axis=-1)
    return jnp.cos(emb).astype(dtype), jnp.sin(emb).astype(dtype)


def apply_rope(x, cos, sin):
    half = QK_ROPE_DIM // 2
    x1, x2 = x[..., :half], x[..., half:]
    rot = jnp.concatenate([-x2, x1], axis=-1)
    return x * cos + rot * sin


def mla_group(c_q, c_kv, k_pe, q_norm_g, w_uq, kv_norm_g, w_uk, w_uv, cos, sin):
    B, L, _ = c_q.shape
    q = (rms_norm(c_q, q_norm_g) @ w_uq).reshape(B, L, MLA_HEADS, QK_HEAD_DIM)
    q_nope, q_pe = q[..., :QK_NOPE_DIM], q[..., QK_NOPE_DIM:]
    q_pe = apply_rope(q_pe, cos[:, None, :], sin[:, None, :])
    ckv = rms_norm(c_kv, kv_norm_g)
    k_nope = (ckv @ w_uk).reshape(B, L, MLA_HEADS, QK_NOPE_DIM)
    v = (ckv @ w_uv).reshape(B, L, MLA_HEADS, V_HEAD_DIM)
    k_pe = apply_rope(k_pe, cos, sin)
    q = jnp.concatenate([q_nope, q_pe], axis=-1)
    k = jnp.concatenate([k_nope, jnp.broadcast_to(k_pe[:, :, None, :], (B, L, MLA_HEADS, QK_ROPE_DIM))], axis=-1)

    n_blocks = -(-L // Q_BLOCK)
    L_pad = n_blocks * Q_BLOCK
    pad = [(0, 0), (0, L_pad - L), (0, 0), (0, 0)]
    q, k, v = jnp.pad(q, pad), jnp.pad(k, pad), jnp.pad(v, pad)
    q_blocks = q.reshape(B, n_blocks, Q_BLOCK, MLA_HEADS, QK_HEAD_DIM).transpose(1, 0, 2, 3, 4)
    k_pos = jnp.arange(L_pad)
    scale = 1.0 / math.sqrt(QK_HEAD_DIM)

    def attend(args):
        qb, start = args
        s = jnp.einsum('bqhd,bkhd->bhqk', qb, k).astype(jnp.float32) * scale
        q_pos = start + jnp.arange(Q_BLOCK)
        mask = k_pos[None, :] <= q_pos[:, None]
        s = jnp.where(mask[None, None], s, -1e30)
        p = jax.nn.softmax(s, axis=-1).astype(v.dtype)
        return jnp.einsum('bhqk,bkhd->bqhd', p, v)

    out = lax.map(attend, (q_blocks, jnp.arange(n_blocks) * Q_BLOCK))
    out = out.transpose(1, 0, 2, 3, 4).reshape(B, L_pad, MLA_WIDTH)
    return out[:, :L]


def conv_group(u, dw_w, dw_b, ln_g, ln_b):
    a, gate = u[..., :CONV_CHANNELS], u[..., CONV_CHANNELS:]
    h = a * jax.nn.sigmoid(gate)
    h = lax.conv_general_dilated(
        h, dw_w[:, None, :], window_strides=(1,), padding=[(CONV_WIDTH - 1, 0)],
        dimension_numbers=('NWC', 'WIO', 'NWC'), feature_group_count=CONV_CHANNELS) + dw_b
    h = layer_norm(h, ln_g, ln_b)
    return jax.nn.silu(h)


def moe(h, w_router, b_router, w1, b1, w2, b2):
    B, L, D = h.shape
    xt = h.reshape(-1, D)
    T = xt.shape[0]
    logits = (xt @ w_router + b_router).astype(jnp.float32)
    top_vals, top_idx = lax.top_k(logits, TOP_K)
    gates = jax.nn.softmax(top_vals, axis=-1)

    TK = T * TOP_K
    expert_flat = top_idx.reshape(-1).astype(jnp.int32)
    token_flat = (jnp.arange(TK, dtype=jnp.int32) // TOP_K)
    gate_flat = gates.reshape(-1)
    order = jnp.argsort(expert_flat)
    e_sorted = expert_flat[order]
    counts = jnp.bincount(expert_flat, length=N_EXPERTS)
    starts = jnp.cumsum(counts) - counts
    padded = (counts + EXPERT_BLOCK - 1) // EXPERT_BLOCK * EXPERT_BLOCK
    pad_ends = jnp.cumsum(padded)
    pad_starts = pad_ends - padded
    dest = pad_starts[e_sorted] + (jnp.arange(TK) - starts[e_sorted])

    n_blocks = -(-TK // EXPERT_BLOCK) + N_EXPERTS
    n_rows = n_blocks * EXPERT_BLOCK
    row_token = jnp.zeros((n_rows,), jnp.int32).at[dest].set(token_flat[order])
    row_gate = jnp.zeros((n_rows,), jnp.float32).at[dest].set(gate_flat[order])
    block_expert = jnp.minimum(
        jnp.searchsorted(pad_ends, jnp.arange(n_blocks) * EXPERT_BLOCK, side='right'), N_EXPERTS - 1)

    def expert_block(args):
        tok, e = args
        xb = xt[tok]
        z = xb @ w1[e] + b1[e]
        g, u = z[:, :D_FF], z[:, D_FF:]
        g = jnp.minimum(g, SWIGLU_LIMIT)
        u = jnp.clip(u, -SWIGLU_LIMIT, SWIGLU_LIMIT)
        act = g * jax.nn.sigmoid(SWIGLU_ALPHA * g) * (u + 1.0)
        return act @ w2[e] + b2[e]

    out = lax.map(expert_block, (row_token.reshape(n_blocks, EXPERT_BLOCK), block_expert))
    out = out.reshape(n_rows, D) * row_gate[:, None].astype(out.dtype)
    y = jnp.zeros_like(xt).at[row_token].add(out)
    return y.reshape(B, L, D)


def setup_inputs(seed: int = 0) -> dict:
    key = jax.random.key(seed)
    ks = jax.random.split(key, 32)
    f32 = jnp.float32

    def nrm(k, shape, fan_in, scale=1.0):
        return jax.random.normal(k, shape, f32) * (scale * fan_in ** -0.5)

    def gain(k, shape):
        return 1.0 + 0.02 * jax.random.normal(k, shape, f32)

    def bias(k, shape, s=0.02):
        return s * jax.random.normal(k, shape, f32)

    Dp = DEPTH
    return {
        "x": jax.random.normal(ks[0], (BATCH, SEQ, D_MODEL), f32),
        "meta_tokens": jax.random.normal(ks[1], (N_META, D_MODEL), f32),
        "ln_in_g": gain(ks[2], (D_MODEL,)),
        "ln_in_b": bias(ks[3], (D_MODEL,)),
        "w_in": nrm(ks[4], (Dp, D_MODEL, IN_PROJ_WIDTH), D_MODEL),
        "q_norm_g": gain(ks[5], (Dp, Q_LORA_RANK)),
        "w_uq": nrm(ks[6], (Dp, Q_LORA_RANK, MLA_HEADS * QK_HEAD_DIM), Q_LORA_RANK),
        "kv_norm_g": gain(ks[7], (Dp, KV_LORA_RANK)),
        "w_uk": nrm(ks[8], (Dp, KV_LORA_RANK, MLA_HEADS * QK_NOPE_DIM), KV_LORA_RANK),
        "w_uv": nrm(ks[9], (Dp, KV_LORA_RANK, MLA_HEADS * V_HEAD_DIM), KV_LORA_RANK, DEEPNORM_BETA),
        "conv_dw_w": nrm(ks[10], (Dp, CONV_WIDTH, CONV_CHANNELS), CONV_WIDTH),
        "conv_dw_b": bias(ks[11], (Dp, CONV_CHANNELS)),
        "conv_ln_g": gain(ks[12], (Dp, CONV_CHANNELS)),
        "conv_ln_b": bias(ks[13], (Dp, CONV_CHANNELS)),
        "w_out": nrm(ks[14], (Dp, MIX_WIDTH, D_MODEL), MIX_WIDTH, DEEPNORM_BETA),
        "ln1_g": gain(ks[15], (Dp, D_MODEL)),
        "ln1_b": bias(ks[16], (Dp, D_MODEL)),
        "w_router": nrm(ks[17], (Dp, D_MODEL, N_EXPERTS), D_MODEL),
        "b_router": bias(ks[18], (Dp, N_EXPERTS), 0.01),
        "w_mlp1": nrm(ks[19], (Dp, N_EXPERTS, D_MODEL, 2 * D_FF), D_MODEL),
        "b_mlp1": bias(ks[20], (Dp, N_EXPERTS, 2 * D_FF)),
        "w_mlp2": nrm(ks[21], (Dp, N_EXPERTS, D_FF, D_MODEL), D_FF, DEEPNORM_BETA),
        "b_mlp2": bias(ks[22], (Dp, N_EXPERTS, D_MODEL)),
        "ln2_g": gain(ks[23], (Dp, D_MODEL)),
        "ln2_b": bias(ks[24], (Dp, D_MODEL)),
    }


def reference(x, meta_tokens, ln_in_g, ln_in_b, w_in, q_norm_g, w_uq, kv_norm_g, w_uk, w_uv,
              conv_dw_w, conv_dw_b, conv_ln_g, conv_ln_b, w_out, ln1_g, ln1_b,
              w_router, b_router, w_mlp1, b_mlp1, w_mlp2, b_mlp2, ln2_g, ln2_b):
    B = x.shape[0]
    meta = jnp.broadcast_to(meta_tokens[None].astype(x.dtype), (B, N_META, D_MODEL))
    h = jnp.concatenate([meta, x], axis=1)
    h = layer_norm(h, ln_in_g, ln_in_b)
    L = h.shape[1]
    cos, sin = rope_tables(L, h.dtype)
    s1 = Q_LORA_RANK
    s2 = s1 + KV_LORA_RANK
    s3 = s2 + QK_ROPE_DIM
    for l in range(DEPTH):
        proj = h @ w_in[l]
        c_q, c_kv, k_pe, u_conv = proj[..., :s1], proj[..., s1:s2], proj[..., s2:s3], proj[..., s3:]
        attn = mla_group(c_q, c_kv, k_pe, q_norm_g[l], w_uq[l], kv_norm_g[l], w_uk[l], w_uv[l], cos, sin)
        conv = conv_group(u_conv, conv_dw_w[l], conv_dw_b[l], conv_ln_g[l], conv_ln_b[l])
        mix = jnp.concatenate([attn, conv], axis=-1) @ w_out[l]
        h = layer_norm(DEEPNORM_ALPHA * h + mix, ln1_g[l], ln1_b[l])
        ffn = moe(h, w_router[l], b_router[l], w_mlp1[l], b_mlp1[l], w_mlp2[l], b_mlp2[l])
        h = layer_norm(DEEPNORM_ALPHA * h + ffn, ln2_g[l], ln2_b[l])
    return h[:, N_META:]
```

```cpp
#include <hip/hip_runtime.h>
#include <cstdio>
#include <cstdint>

typedef unsigned short bf16;
typedef __bf16 bf16x2v __attribute__((ext_vector_type(2)));
__device__ __forceinline__ float bf2f(bf16 v) { return __uint_as_float(((unsigned)v) << 16); }
__device__ __forceinline__ bf16 f2bf(float f) { unsigned u = __float_as_uint(f); return (bf16)((u + 0x7fffu + ((u >> 16) & 1u)) >> 16); }

constexpr int D = 2048, NB = 4, S = 2048, NMETA = 16, LSEQ = S + NMETA;
constexpr int T = NB * S;
constexpr int MROWS = 8448;
constexpr int NH = 8, DQK = 192, DNOPE = 128, DROPE = 64, DV = 128;
constexpr int QL = 768, KVL = 512, CC = 1024, CW = 31;
constexpr int NPROJ = 3392, NPROJP = 3584;
constexpr int PC_Q = 0, PC_KV = 768, PC_A = 1280, PC_G = 2304, PC_KPE = 3328;
constexpr int NE = 32, TOPK = 4, DFF = 2048, CAP = 8192;
constexpr int KPAD = 2112;
constexpr float ALPHA = 1.189207115002721f;
constexpr float LN_EPS = 1e-5f, RMS_EPS = 1e-6f;
constexpr float SW_LIMIT = 7.0f, SW_ALPHA = 1.702f;

constexpr size_t MiB = 1ull << 20;
constexpr size_t WS_CTL = 0, CTL_BYTES = 64 * 1024;
constexpr size_t WS_ROPE = 1 * MiB;
constexpr size_t WS_WTIN = 2 * MiB, WS_WTUQ = 18 * MiB, WS_WTKV = 21 * MiB, WS_WTOUT = 23 * MiB;
constexpr size_t WS_RSC = 48 * MiB, WS_CSC = 49 * MiB;
constexpr size_t WS_SSQP = 32 * MiB, WS_H0B = 96 * MiB, WS_PROJ = 130 * MiB, WS_Q = 188 * MiB, WS_K = 212 * MiB, WS_V = 237 * MiB;
constexpr size_t WS_MIX = 254 * MiB, WS_X1 = 286 * MiB, WS_H1B = 350 * MiB, WS_ROUTE = 414 * MiB;
constexpr size_t WS_WT1 = 416 * MiB, WS_WT2 = 672 * MiB, WS_XG = 800 * MiB, WS_ACT = 1312 * MiB, WS_EO = 1824 * MiB, WS_END = 2848 * MiB;
constexpr float F8_SX = 4.0f, F8_SW = 256.0f, F8_INV = 1.0f / (F8_SX * F8_SW), F8_SE = 64.0f;
constexpr int CW_CNT = 8192;
constexpr int CW_LNSTAT = 65536;

__device__ __forceinline__ int proj_src_col(int np) {
    if (np < 1280) return np;
    if (np < 3328) return np + 64;
    if (np < 3392) { const int i = np - 3328; return 1280 + (i >> 1) + 32 * (i & 1); }
    return -1;
}

__host__ __device__ __forceinline__ int keypos(int key) { return (key & ~31) | ((key & 0x0C) << 1) | ((key & 0x10) >> 2) | (key & 3); }

__device__ __forceinline__ float wave_sum(float v) {
#pragma unroll
    for (int o = 1; o < 64; o <<= 1) v += __shfl_xor(v, o);
    return v;
}

typedef float f32x4_t __attribute__((ext_vector_type(4)));
typedef unsigned u32x2_t __attribute__((ext_vector_type(2)));
__device__ __forceinline__ unsigned pk2_rne(float lo, float hi) { return (unsigned)f2bf(lo) | ((unsigned)f2bf(hi) << 16); }
__device__ __forceinline__ void ln_row(const float* src, const float* g, const float* b, float* stats2, bf16* dstb, int lane) {
    f32x4_t v[8]; float s = 0.f;
#pragma unroll
    for (int j = 0; j < 8; ++j) { v[j] = *(const f32x4_t*)(src + 4 * lane + 256 * j); s += (v[j][0] + v[j][1]) + (v[j][2] + v[j][3]); }
    const float mean = wave_sum(s) * (1.f / D); float s2 = 0.f;
#pragma unroll
    for (int j = 0; j < 8; ++j) { v[j] = v[j] - mean; s2 += (v[j][0] * v[j][0] + v[j][1] * v[j][1]) + (v[j][2] * v[j][2] + v[j][3] * v[j][3]); }
    const float rstd = 1.0f / sqrtf(wave_sum(s2) * (1.f / D) + LN_EPS);
    if (stats2 && lane == 0) { stats2[0] = mean; stats2[1] = rstd; }
#pragma unroll
    for (int j = 0; j < 8; ++j) { const int c = 4 * lane + 256 * j; const f32x4_t gg = *(const f32x4_t*)(g + c), bb = *(const f32x4_t*)(b + c);
        const f32x4_t o = v[j] * rstd * gg + bb; u32x2_t w; w.x = pk2_rne(o[0], o[1]); w.y = pk2_rne(o[2], o[3]); *(u32x2_t*)(dstb + c) = w; }
}

__device__ __forceinline__ float wave_max(float v) {
#pragma unroll
    for (int o = 32; o > 0; o >>= 1) v = fmaxf(v, __shfl_xor(v, o));
    return v;
}
__device__ __forceinline__ unsigned pack_i8x4(float a, float b, float c, float d) {
    const int ia = (int)a, ib = (int)b, ic = (int)c, id = (int)d;
    return (unsigned)(ia & 255) | ((unsigned)(ib & 255) << 8) | ((unsigned)(ic & 255) << 16) | ((unsigned)id << 24);
}
__device__ __forceinline__ void ln_row8(const float* src, const float* g, const float* b, float* stats2, unsigned char* dst8, float* rsc, int lane) {
    f32x4_t v[8]; float s = 0.f;
#pragma unroll
    for (int j = 0; j < 8; ++j) { v[j] = *(const f32x4_t*)(src + 4 * lane + 256 * j); s += (v[j][0] + v[j][1]) + (v[j][2] + v[j][3]); }
    const float mean = wave_sum(s) * (1.f / D); float s2 = 0.f;
#pragma unroll
    for (int j = 0; j < 8; ++j) { v[j] = v[j] - mean; s2 += (v[j][0] * v[j][0] + v[j][1] * v[j][1]) + (v[j][2] * v[j][2] + v[j][3] * v[j][3]); }
    const float rstd = 1.0f / sqrtf(wave_sum(s2) * (1.f / D) + LN_EPS);
    if (stats2 && lane == 0) { stats2[0] = mean; stats2[1] = rstd; }
    float am = 0.f;
#pragma unroll
    for (int j = 0; j < 8; ++j) { const int c = 4 * lane + 256 * j; const f32x4_t gg = *(const f32x4_t*)(g + c), bb = *(const f32x4_t*)(b + c);
        v[j] = v[j] * rstd * gg + bb; am = fmaxf(fmaxf(am, fmaxf(fabsf(v[j][0]), fabsf(v[j][1]))), fmaxf(fabsf(v[j][2]), fabsf(v[j][3]))); }
    am = wave_max(am);
    const float inv = am > 0.f ? 127.0f / am : 0.f;
    if (lane == 0) *rsc = am * (1.0f / 127.0f);
#pragma unroll
    for (int j = 0; j < 8; ++j) { const f32x4_t q = v[j] * inv; *(unsigned*)(dst8 + 4 * lane + 256 * j) = pack_i8x4(rintf(q[0]), rintf(q[1]), rintf(q[2]), rintf(q[3])); }
}

constexpr float MIX_S = 16.0f;
constexpr float QSCALE = 0.07216878364870323f * 1.4426950408889634f;

constexpr int TIDTAB_OFF = 153600 + 1024;
extern __shared__ __attribute__((aligned(16))) unsigned char lds_raw[];
__device__ __forceinline__ int hw_slot() { return (int)(__builtin_amdgcn_s_getreg((5 << 11) | 4) & 63u); }
__device__ __forceinline__ int my_lane() { int l; asm volatile("v_mbcnt_lo_u32_b32 %0, -1, 0\n\tv_mbcnt_hi_u32_b32 %0, -1, %0" : "=v"(l)); return l; }
__device__ __forceinline__ int my_tid() {
    const int wv = ((const __attribute__((address_space(3))) int*)((__attribute__((address_space(3))) unsigned char*)lds_raw + TIDTAB_OFF))[hw_slot()];
    return __builtin_amdgcn_readfirstlane(wv) * 64 + my_lane();
}
namespace pg8 {
#define PG8_LAS __attribute__((address_space(3)))
typedef unsigned short bf16_t;
typedef short bf16x8 __attribute__((ext_vector_type(8)));
typedef float f32x4 __attribute__((ext_vector_type(4)));
typedef unsigned u32x4 __attribute__((ext_vector_type(4)));
constexpr int BM = 256, BK = 64, HALF = 128, HTB = HALF * BK * 2, STAGE_BYTES = 8 * HTB, NXCD = 8, WGM = 8;

__host__ __device__ __forceinline__ int lds_byte(int r, int c) { const int st = (r >> 4) * 2 + (c >> 5), rr = r & 15, cc = c & 31, ob = rr * 64 + cc * 2; return st * 1024 + (ob ^ (((ob >> 9) & 1) << 5)); }
__host__ __device__ __forceinline__ void stage_rc(int b, int& R, int& C) { const int st = b / 1024, sb = b % 1024, swz = sb ^ (((sb >> 9) & 1) << 5); R = (st >> 1) * 16 + swz / 64; C = (st & 1) * 32 + (swz % 64) / 2; }
__host__ __device__ __forceinline__ int perm32(int rho) { const int n = rho >> 4, i = rho & 15; return 8 * (i >> 2) + 4 * n + (i & 3); }

struct Unit { int pm, pn; };
struct Gemm { const bf16_t* A; const bf16_t* Bt; int K, lda, ldb; };

struct StaticOrder {
    int nM, nN, nwg, G, c;
    __device__ void init(int nM_, int nN_, int G_, int c_) { nM = nM_; nN = nN_; nwg = nM * nN; G = G_; c = c_; }
    __device__ bool next(int i, Unit& u) const {
        const long L = (long)i * G + c; if (L >= nwg) return false;
        int wgid = (int)L; { const int q = nwg / NXCD, r = nwg % NXCD, xcd = wgid % NXCD, off = wgid / NXCD; wgid = (xcd < r ? xcd * (q + 1) : r * (q + 1) + (xcd - r) * q) + off; }
        const int nig = WGM * nN, gid = wgid / nig, fm = gid * WGM, gsz = (nM - fm) < WGM ? (nM - fm) : WGM;
        u.pm = fm + ((wgid % nig) % gsz); u.pn = (wgid % nig) / gsz; return true;
    }
};

typedef float f32x2v __attribute__((ext_vector_type(2)));
__device__ __forceinline__ unsigned cvt_pk_bf16(float lo, float hi) { const f32x2v f = {lo, hi}; const bf16x2v b = __builtin_convertvector(f, bf16x2v); return __builtin_bit_cast(unsigned, b); }

typedef int v8i_t __attribute__((ext_vector_type(8)));
typedef int v4i_t __attribute__((ext_vector_type(4)));
template <class Epi, class Sched, bool ALIGN_EPI = false, bool SP2 = false, bool F8 = false, bool SWAP = false, bool I8 = false>
__device__ __forceinline__ void gemm_phase(PG8_LAS unsigned char* lds, const Gemm g, const Sched& S, const Epi& E) {
    const int tid = my_tid(), wid = __builtin_amdgcn_readfirstlane(tid >> 6), lane = tid & 63, wr = wid >> 2, wc = wid & 3, fr = lane & 15, fq = lane >> 4;
    const int K = g.K, nt = K / BK;
    unsigned voffA[2], voffB[2];
#pragma unroll
    for (int i = 0; i < 2; ++i) { int R, C; stage_rc(tid * 16 + i * 8192, R, C); const int Rb = Epi::PERM ? ((R & ~31) + perm32(R & 31)) : R;
        voffA[i] = (unsigned)(R * g.lda + C) * 2u; voffB[i] = (unsigned)(Rb * g.ldb + C) * 2u; }
    const size_t kstep = (size_t)(BK * 2);
    const size_t hstepA = (size_t)HALF * g.lda * 2, hstepB = (size_t)HALF * g.ldb * 2;
    const size_t tstepA = 2 * hstepA, tstepB = 2 * hstepB;
    const unsigned ldsw = (unsigned)wid * 1024u;
    const int aoff = lds_byte(wr * 64 + fr, fq * 8), boff = lds_byte(wc * 32 + fr, fq * 8);
#define PG8_SA(b, h) (((b) * 2 + (h)) * HTB)
#define PG8_SB(b, h) ((4 + (b) * 2 + (h)) * HTB)
#define PG8_STAGE(bufoff, gbase, voff) do { _Pragma("unroll") for (int _i = 0; _i < 2; ++_i) \
        __builtin_amdgcn_global_load_lds((const unsigned*)((const char*)(gbase) + (voff)[_i]), (PG8_LAS unsigned*)(lds + (bufoff) + ldsw + _i * 8192), 16, 0, 0); } while (0)
#define PG8_LDA(dst, b, h) do { _Pragma("unroll") for (int m = 0; m < 4; ++m) _Pragma("unroll") for (int k = 0; k < 2; ++k) dst[m][k] = *(const PG8_LAS bf16x8*)(lds + PG8_SA(b, h) + aoff + m * 2048 + k * 1024); } while (0)
#define PG8_LDB(dst, b, h) do { _Pragma("unroll") for (int n = 0; n < 2; ++n) _Pragma("unroll") for (int k = 0; k < 2; ++k) dst[n][k] = *(const PG8_LAS bf16x8*)(lds + PG8_SB(b, h) + boff + n * 2048 + k * 1024); } while (0)
#define PG8_MMA(ai, bj, At, Bt) do { __builtin_amdgcn_s_setprio(1); \
        if constexpr (F8) { _Pragma("unroll") for (int m = 0; m < 4; ++m) _Pragma("unroll") for (int n = 0; n < 2; ++n) \
            asm volatile("v_mfma_scale_f32_16x16x128_f8f6f4 %0, %1, %2, %0, %3, %3 op_sel_hi:[0,0,0]" : "+v"(acc[ai][bj][m][n]) \
                : "v"(__builtin_shufflevector(__builtin_bit_cast(v4i_t, Bt[n][0]), __builtin_bit_cast(v4i_t, Bt[n][1]), 0, 1, 2, 3, 4, 5, 6, 7)), \
                  "v"(__builtin_shufflevector(__builtin_bit_cast(v4i_t, At[m][0]), __builtin_bit_cast(v4i_t, At[m][1]), 0, 1, 2, 3, 4, 5, 6, 7)), "v"(f8scale)); } \
        else if constexpr (I8) { _Pragma("unroll") for (int m = 0; m < 4; ++m) _Pragma("unroll") for (int n = 0; n < 2; ++n) _Pragma("unroll") for (int k = 0; k < 2; ++k) \
            acc[ai][bj][m][n] = __builtin_bit_cast(f32x4, __builtin_amdgcn_mfma_i32_16x16x64_i8(__builtin_bit_cast(v4i_t, Bt[n][k]), __builtin_bit_cast(v4i_t, At[m][k]), __builtin_bit_cast(v4i_t, acc[ai][bj][m][n]), 0, 0, 0)); } \
        else { _Pragma("unroll") for (int m = 0; m < 4; ++m) _Pragma("unroll") for (int n = 0; n < 2; ++n) _Pragma("unroll") for (int k = 0; k < 2; ++k) \
            acc[ai][bj][m][n] = SWAP ? __builtin_amdgcn_mfma_f32_16x16x32_bf16(At[m][k], Bt[n][k], acc[ai][bj][m][n], 0, 0, 0) \
                                     : __builtin_amdgcn_mfma_f32_16x16x32_bf16(Bt[n][k], At[m][k], acc[ai][bj][m][n], 0, 0, 0); } \
        __builtin_amdgcn_s_setprio(0); } while (0)
#define PG8_WAIT_V(n) asm volatile("s_waitcnt vmcnt(" #n ")" ::: "memory")
#define PG8_WAIT_L(n) asm volatile("s_waitcnt lgkmcnt(" #n ")" ::: "memory")
#define PG8_BAR __builtin_amdgcn_s_barrier()
#define PG8_SCHED __builtin_amdgcn_sched_barrier(0)
    Unit cur, nxt; int ui = 0;
    if (!S.next(0, cur)) return;
    int f8scale = 0x7F7F7F7F; asm volatile("" : "+v"(f8scale));
    f32x4 acc[2][2][4][2];
#pragma unroll
    for (int a = 0; a < 2; ++a)
#pragma unroll
        for (int b = 0; b < 2; ++b)
#pragma unroll
            for (int m = 0; m < 4; ++m)
#pragma unroll
                for (int n = 0; n < 2; ++n) acc[a][b][m][n] = (f32x4){0.f, 0.f, 0.f, 0.f};
    bf16x8 At[4][2], B0[2][2], B1[2][2];
    const char* cA = (const char*)g.A + (size_t)cur.pm * tstepA; const char* cB = (const char*)g.Bt + (size_t)cur.pn * tstepB;
    if constexpr (SP2) {
        PG8_STAGE(PG8_SB(0, 0), cB, voffB); PG8_STAGE(PG8_SB(0, 1), cB + hstepB, voffB); PG8_STAGE(PG8_SA(0, 0), cA, voffA); PG8_STAGE(PG8_SA(0, 1), cA + hstepA, voffA);
        if (wr == 1) PG8_BAR;
        PG8_WAIT_V(2); PG8_BAR;
        PG8_STAGE(PG8_SB(1, 0), cB + kstep, voffB); PG8_STAGE(PG8_SA(1, 0), cA + kstep, voffA); PG8_STAGE(PG8_SB(1, 1), cB + hstepB + kstep, voffB);
        PG8_WAIT_V(6); PG8_BAR;
    } else {
        PG8_STAGE(PG8_SB(0, 0), cB, voffB); PG8_STAGE(PG8_SA(0, 0), cA, voffA); PG8_STAGE(PG8_SB(0, 1), cB + hstepB, voffB); PG8_STAGE(PG8_SA(0, 1), cA + hstepA, voffA);
        if (wr == 1) PG8_BAR;
        PG8_WAIT_V(4); PG8_BAR;
        PG8_STAGE(PG8_SB(1, 0), cB + kstep, voffB); PG8_STAGE(PG8_SA(1, 0), cA + kstep, voffA); PG8_STAGE(PG8_SB(1, 1), cB + hstepB + kstep, voffB);
        PG8_WAIT_V(6); PG8_BAR;
    }
    for (;;) {
        const bool has_next = S.next(ui + 1, nxt);
        if constexpr (Epi::STAGED) E.pre(cur, ui, wid, lane);
        const char* nA = has_next ? (const char*)g.A + (size_t)nxt.pm * tstepA : cA; const char* nB = has_next ? (const char*)g.Bt + (size_t)nxt.pn * tstepB : cB;
        for (int t = 0; t < nt; t += 2) {
            const bool last = (t == nt - 2);
            const char* a1 = cA + (size_t)(t + 1) * kstep;
            const char* a2 = last ? nA : cA + (size_t)(t + 2) * kstep; const char* b2 = last ? nB : cB + (size_t)(t + 2) * kstep;
            const char* a3 = a2 + kstep; const char* b3 = b2 + kstep;
            if constexpr (SP2) {
            PG8_LDB(B0, 0, 0); PG8_LDB(B1, 0, 1); PG8_SCHED; PG8_LDA(At, 0, 0); PG8_STAGE(PG8_SA(1, 1), a1 + hstepA, voffA);
            PG8_WAIT_V(8); PG8_WAIT_L(0); PG8_BAR; PG8_MMA(0, 0, At, B0); PG8_MMA(0, 1, At, B1); PG8_BAR; PG8_SCHED;
            PG8_LDA(At, 0, 1); PG8_STAGE(PG8_SB(0, 0), b2, voffB); PG8_STAGE(PG8_SB(0, 1), b2 + hstepB, voffB); PG8_STAGE(PG8_SA(0, 0), a2, voffA);
            PG8_WAIT_V(8); PG8_WAIT_L(0); PG8_BAR; PG8_MMA(1, 0, At, B0); PG8_MMA(1, 1, At, B1); PG8_BAR; PG8_SCHED;
            PG8_LDB(B0, 1, 0); PG8_LDB(B1, 1, 1); PG8_SCHED; PG8_LDA(At, 1, 0); PG8_STAGE(PG8_SA(0, 1), a2 + hstepA, voffA);
            PG8_WAIT_V(8); PG8_WAIT_L(0); PG8_BAR; PG8_MMA(0, 0, At, B0); PG8_MMA(0, 1, At, B1); PG8_BAR; PG8_SCHED;
            PG8_LDA(At, 1, 1); PG8_STAGE(PG8_SB(1, 0), b3, voffB); PG8_STAGE(PG8_SB(1, 1), b3 + hstepB, voffB); PG8_STAGE(PG8_SA(1, 0), a3, voffA);
            PG8_WAIT_V(8); PG8_WAIT_L(0); PG8_BAR; PG8_MMA(1, 0, At, B0); PG8_MMA(1, 1, At, B1); PG8_BAR; PG8_SCHED;
            } else {
            PG8_LDB(B0, 0, 0); PG8_SCHED; PG8_LDA(At, 0, 0); PG8_STAGE(PG8_SA(1, 1), a1 + hstepA, voffA);
            PG8_WAIT_L(8); PG8_BAR; PG8_WAIT_L(0); PG8_MMA(0, 0, At, B0); PG8_BAR; PG8_SCHED;
            PG8_LDB(B1, 0, 1); PG8_STAGE(PG8_SB(0, 0), b2, voffB);
            PG8_BAR; PG8_WAIT_L(0); PG8_MMA(0, 1, At, B1); PG8_BAR;
            PG8_LDA(At, 0, 1); PG8_STAGE(PG8_SA(0, 0), a2, voffA);
            PG8_BAR; PG8_WAIT_L(0); PG8_MMA(1, 0, At, B0); PG8_BAR; PG8_SCHED;
            PG8_STAGE(PG8_SB(0, 1), b2 + hstepB, voffB);
            PG8_WAIT_V(6); PG8_BAR; PG8_MMA(1, 1, At, B1); PG8_BAR;
            PG8_LDB(B0, 1, 0); PG8_SCHED; PG8_LDA(At, 1, 0); PG8_STAGE(PG8_SA(0, 1), a2 + hstepA, voffA);
            PG8_WAIT_L(8); PG8_BAR; PG8_WAIT_L(0); PG8_MMA(0, 0, At, B0); PG8_BAR; PG8_SCHED;
            PG8_LDB(B1, 1, 1); PG8_STAGE(PG8_SB(1, 0), b3, voffB);
            PG8_BAR; PG8_WAIT_L(0); PG8_MMA(0, 1, At, B1); PG8_BAR;
            PG8_LDA(At, 1, 1); PG8_STAGE(PG8_SA(1, 0), a3, voffA);
            PG8_BAR; PG8_WAIT_L(0); PG8_MMA(1, 0, At, B0); PG8_BAR; PG8_SCHED;
            PG8_STAGE(PG8_SB(1, 1), b3 + hstepB, voffB);
            PG8_WAIT_V(6); PG8_BAR; PG8_MMA(1, 1, At, B1); PG8_BAR;
            }
        }
        if constexpr (F8) asm volatile("s_nop 15\n\ts_nop 15" ::: "memory");
        if constexpr (ALIGN_EPI) { if (wr == 0) PG8_BAR; }
        { int tz = my_tid(); asm volatile("" : "+v"(tz));
          const int lz = tz & 63; if constexpr (Epi::STAGED) E.run(acc, cur, wr, wc, lz & 15, lz >> 4, tz, ui); else E(acc, cur, wr, wc, lz & 15, lz >> 4); }
        if (!has_next) break;
#pragma unroll
        for (int a = 0; a < 2; ++a)
#pragma unroll
            for (int b = 0; b < 2; ++b)
#pragma unroll
                for (int m = 0; m < 4; ++m)
#pragma unroll
                    for (int n = 0; n < 2; ++n) acc[a][b][m][n] = (f32x4){0.f, 0.f, 0.f, 0.f};
        cur = nxt; cA = nA; cB = nB; ++ui;
        if constexpr (ALIGN_EPI) { if (wr == 1) PG8_BAR; }
    }
    PG8_WAIT_V(0);
    if constexpr (!ALIGN_EPI) { if (wr == 0) PG8_BAR; }
    PG8_BAR;
#undef PG8_SA
#undef PG8_SB
#undef PG8_STAGE
#undef PG8_LDA
#undef PG8_LDB
#undef PG8_MMA
#undef PG8_WAIT_V
#undef PG8_WAIT_L
#undef PG8_BAR
#undef PG8_SCHED
}
}

#define GAS __attribute__((address_space(1)))
#define LAS __attribute__((address_space(3)))
typedef unsigned v4u __attribute__((ext_vector_type(4)));
typedef unsigned v2u __attribute__((ext_vector_type(2)));
typedef float f32x4 __attribute__((ext_vector_type(4)));
typedef short bf16x8 __attribute__((ext_vector_type(8)));
#define LDS_WAIT() asm volatile("s_waitcnt lgkmcnt(0)" ::: "memory")
#define VM_WAIT() asm volatile("s_waitcnt vmcnt(0)" ::: "memory")
__device__ __forceinline__ unsigned pk2(float lo, float hi) { return pg8::cvt_pk_bf16(lo, hi); }

constexpr int NWAVES = 8, NTHR = 512;
constexpr int CONV_P3_PER_WAVE = 14, CONV_P2_PER_WAVE = 8, CONV_P4_PER_WAVE = 5, CONV_P5_PER_WAVE = 3;
constexpr int CONV_W1B = 16 * 2048, CONV_W2 = 32 * 2048, CONV_END = 32 * 2048 + 32 * 1024;
constexpr int CONV_P1 = 50 * 8 * 7;
constexpr int RING_BYTES = 131072, MISC_OFF = 153600, LDS_BYTES = 155648;
constexpr int CW_BAR = 4096;

#define XB_TMO      128
#define XB_XCNT(j)  (256  + 64 * (j))
#define XB_XSUB(j)  (1280 + 64 * (j))
#define XB_XGEN(j)  (2304 + 64 * (j))
#define XB_TOP      3328
#define XB_TOPGEN   3392
#define XCD_BAR_WORDS 3456
#define XB_SPIN_CAP (1u << 18)
__device__ __forceinline__ unsigned xb_ld(unsigned* p)              { return __hip_atomic_load(p, __ATOMIC_RELAXED, __HIP_MEMORY_SCOPE_AGENT); }
__device__ __forceinline__ unsigned xb_add(unsigned* p, unsigned v) { return __hip_atomic_fetch_add(p, v, __ATOMIC_RELAXED, __HIP_MEMORY_SCOPE_AGENT); }
__device__ __forceinline__ unsigned xb_xcc_id() { return (unsigned)__builtin_amdgcn_s_getreg((3 << 11) | 20) & 0xFu; }
#define XB_SPIN(cond, bar) do { unsigned _sp = 0; while (cond) { __builtin_amdgcn_s_sleep(1); \
    if ((++_sp & 255u) == 0u) { if (xb_ld(&(bar)[XB_TMO])) break; if (_sp > XB_SPIN_CAP) { atomicAdd(&(bar)[XB_TMO], 1u); break; } } } } while (0)
struct XcdBarrier { unsigned* bar; unsigned x; volatile LAS unsigned* st; };
__device__ __forceinline__ XcdBarrier xcd_barrier_post(unsigned* bar, volatile LAS unsigned* st) {
    XcdBarrier b; b.bar = bar; b.x = xb_xcc_id(); b.st = st;
    if (my_tid() == 0) (void)xb_add(&bar[XB_XCNT(b.x)], 1u);
    return b;
}
__device__ __forceinline__ void xcd_barrier_complete(unsigned* bar, unsigned x, unsigned& nloc, unsigned& nx) {
    const unsigned G = gridDim.x * gridDim.y * gridDim.z;
    unsigned sum, cnt, mine, sp = 0u;
    for (;;) {
        sum = 0u; cnt = 0u; mine = 0u;
#pragma unroll
        for (unsigned j = 0; j < 16; ++j) { const unsigned c = xb_ld(&bar[XB_XCNT(j)]); sum += c; cnt += (c > 0u) ? 1u : 0u; mine = (j == x) ? c : mine; }
        if (sum == G) break;
        __builtin_amdgcn_s_sleep(1);
        if ((++sp & 255u) == 0u) { if (xb_ld(&bar[XB_TMO])) break; if (sp > XB_SPIN_CAP) { atomicAdd(&bar[XB_TMO], 1u); break; } }
    }
    nloc = mine > 0u ? mine : 1u; nx = cnt > 0u ? cnt : 1u;
}
__device__ __forceinline__ void xcd_barrier(const XcdBarrier& b) {
    asm volatile("s_waitcnt vmcnt(0)" ::: "memory");
    __syncthreads();
    if (my_tid() == 0) {
        unsigned* bar = b.bar;
        __builtin_amdgcn_s_waitcnt(0);
        unsigned nloc = b.st[0], nx = b.st[1];
        if (nloc == 0u) { xcd_barrier_complete(bar, b.x, nloc, nx); b.st[0] = nloc; b.st[1] = nx; }
        const unsigned old = xb_add(&bar[XB_XSUB(b.x)], 1u);
        const unsigned gen = old / nloc;
        if (old + 1u == (gen + 1u) * nloc) {
            __builtin_amdgcn_fence(__ATOMIC_RELEASE, "agent");
            asm volatile("s_waitcnt vmcnt(0)" ::: "memory");
            const unsigned og = xb_add(&bar[XB_TOP], 1u);
            const unsigned tg = og / nx;
            if (og + 1u == (tg + 1u) * nx) xb_add(&bar[XB_TOPGEN], 1u);
            else XB_SPIN(xb_ld(&bar[XB_TOPGEN]) == tg, bar);
            __builtin_amdgcn_fence(__ATOMIC_ACQUIRE, "agent");
            xb_add(&bar[XB_XGEN(b.x)], 1u);
            asm volatile("s_waitcnt vmcnt(0)" ::: "memory");
        } else {
            XB_SPIN(xb_ld(&bar[XB_XGEN(b.x)]) == gen, bar);
            __builtin_amdgcn_fence(__ATOMIC_ACQUIRE, "agent");
            asm volatile("s_waitcnt vmcnt(0)" ::: "memory");
        }
    }
    __syncthreads();
}

struct Args { const float* in[25]; float* out; unsigned char* ws; int ph_lo, ph_hi; };

template <class SrcCol>
__device__ __forceinline__ void transpose_item(const float* W, int ldw, int K, bf16* WT, int n0, int k0, const SrcCol& sc, const float* kscale, LAS float* scr, int lane) {
    const int csrc = sc(n0 + (lane & 31));
#pragma unroll 8
    for (int i = 0; i < 32; ++i) { const int kk = 2 * i + (lane >> 5);
        float v = 0.f; if (csrc >= 0) { v = W[(size_t)(k0 + kk) * ldw + csrc]; if (kscale) v *= kscale[k0 + kk]; }
        scr[kk * 33 + (lane & 31)] = v; }
    LDS_WAIT(); asm volatile("" ::: "memory");
    const int c = lane & 7;
#pragma unroll
    for (int j = 0; j < 4; ++j) { const int n = (lane >> 3) + 8 * j; const LAS float* s = scr + (8 * c) * 33 + n;
        v4u o; o.x = pk2(s[0 * 33], s[1 * 33]); o.y = pk2(s[2 * 33], s[3 * 33]); o.z = pk2(s[4 * 33], s[5 * 33]); o.w = pk2(s[6 * 33], s[7 * 33]);
        *(v4u*)(WT + (size_t)(n0 + n) * K + k0 + 8 * c) = o; }
    LDS_WAIT(); asm volatile("" ::: "memory");
}

typedef short v4i16_t __attribute__((ext_vector_type(4)));
__device__ __forceinline__ int tsw(int kk) { return ((kk >> 1) & 1) | (((kk >> 4) & 1) << 1); }
typedef short s16x2_t __attribute__((ext_vector_type(2)));
__device__ __forceinline__ unsigned f8x4(unsigned lo2, unsigned hi2) {
    s16x2_t r = {0, 0};
    r = __builtin_amdgcn_cvt_scalef32_pk_fp8_bf16(r, __builtin_bit_cast(bf16x2v, lo2), 1.0f / F8_SW, false);
    r = __builtin_amdgcn_cvt_scalef32_pk_fp8_bf16(r, __builtin_bit_cast(bf16x2v, hi2), 1.0f / F8_SW, true);
    return __builtin_bit_cast(unsigned, r);
}
struct TI64 { const float* src; unsigned char* dst; int ldw, K; };
__device__ __forceinline__ TI64 ti64_desc(int it, const float* w1, const float* w2, unsigned char* wt1, unsigned char* wt2, int lane) {
    constexpr int I1 = (D / 128) * (4096 / 32), I2 = (DFF / 128) * (D / 32);
    const int r8 = lane >> 3, c8 = lane & 7; TI64 t;
    if (it < NE * I1) { const int e = it / I1, r = it - e * I1, nb = r & 127, kb = r >> 7; const int pn = nb >> 3, j0 = (nb & 7) * 32;
        const int src0 = (j0 < 128) ? (128 * pn + j0) : (2048 + 128 * pn + j0 - 128);
        t.ldw = 4096; t.K = D; t.src = w1 + (size_t)e * D * 4096 + (size_t)(128 * kb + r8) * 4096 + src0 + 4 * c8; t.dst = wt1 + (size_t)e * 4096 * D + (size_t)(32 * nb) * D + 128 * kb; }
    else { const int q = it - NE * I1, e = q / I2, r = q - e * I2, nb = r & 63, kb = r >> 6;
        t.ldw = D; t.K = DFF; t.src = w2 + (size_t)e * DFF * D + (size_t)(128 * kb + r8) * D + 32 * nb + 4 * c8; t.dst = wt2 + (size_t)e * D * DFF + (size_t)(32 * nb) * DFF + 128 * kb; }
    return t;
}
__device__ __forceinline__ void ti64_load(const TI64& t, f32x4 (&v)[16]) {
#pragma unroll
    for (int i = 0; i < 16; ++i) v[i] = __builtin_nontemporal_load((const f32x4*)(t.src + (size_t)(8 * i) * t.ldw));
}
__device__ __forceinline__ void ti64_store(const TI64& t, const f32x4 (&v)[16], LAS unsigned char* tile, int lane) {
    const int r8 = lane >> 3, c8 = lane & 7;
#pragma unroll
    for (int i = 0; i < 16; ++i) { const int kk = 8 * i + r8;
        v2u o; o.x = pg8::cvt_pk_bf16(v[i][0], v[i][1]); o.y = pg8::cvt_pk_bf16(v[i][2], v[i][3]);
        *(LAS v2u*)(tile + kk * 64 + ((((c8 >> 2) ^ (kk >> 4)) & 1) << 5) + ((c8 & 3) << 3)) = o; }
    asm volatile("" ::: "memory");
    const int G = lane >> 4, i16 = lane & 15, q = i16 >> 2, p = i16 & 3; const bool hi = i16 >= 8;
#pragma unroll
    for (int nbu = 0; nbu < 2; ++nbu) { unsigned oe[4], oo[4];
#pragma unroll
        for (int h = 0; h < 2; ++h) { const int c = 4 * h + G;
#pragma unroll
            for (int j = 0; j < 4; ++j) { const int kk = 16 * c + 4 * j + q;
                const v4i16_t tr = __builtin_amdgcn_ds_read_tr16_b64_v4i16((LAS v4i16_t*)(tile + kk * 64 + (((nbu ^ c) & 1) << 5) + (p << 3)));
                const v2u tu = __builtin_bit_cast(v2u, tr); (h ? oo : oe)[j] = f8x4(tu.x, tu.y); } }
        v4u sa, sb;
#pragma unroll
        for (int j = 0; j < 4; ++j) { const unsigned send = hi ? oe[j] : oo[j]; const unsigned recv = (unsigned)__builtin_amdgcn_mov_dpp((int)send, 0x128, 0xf, 0xf, true);
            const unsigned a_ = hi ? recv : oe[j], b_ = hi ? oo[j] : recv; sa[j] = a_; sb[j] = b_; }
        unsigned char* rowp = t.dst + (size_t)(16 * nbu + (i16 & 7)) * t.K + 16 * (G + (hi ? 4 : 0));
        __builtin_nontemporal_store(sa, (v4u*)rowp);
        __builtin_nontemporal_store(sb, (v4u*)(rowp + (size_t)8 * t.K)); }
    asm volatile("" ::: "memory");
}

__device__ __forceinline__ void tb16_item(const float* W, int ldw, int K, bf16* WT, int n0, int src0, int k0, const float* kscale, LAS unsigned char* tile, int lane) {
    const int r8 = lane >> 3, c8 = lane & 7;
    f32x4 v[16];
    const float* src = W + (size_t)(k0 + r8) * ldw + src0 + 4 * c8;
#pragma unroll
    for (int i = 0; i < 16; ++i) v[i] = __builtin_nontemporal_load((const f32x4*)(src + (size_t)(8 * i) * ldw));
#pragma unroll
    for (int i = 0; i < 16; ++i) { const int kk = 8 * i + r8; const float sc = kscale ? kscale[k0 + kk] : 1.0f;
        v2u o; o.x = pg8::cvt_pk_bf16(v[i][0] * sc, v[i][1] * sc); o.y = pg8::cvt_pk_bf16(v[i][2] * sc, v[i][3] * sc);
        *(LAS v2u*)(tile + kk * 64 + ((((c8 >> 2) ^ (kk >> 4)) & 1) << 5) + ((c8 & 3) << 3)) = o; }
    asm volatile("" ::: "memory");
    const int G = lane >> 4, i16 = lane & 15, q = i16 >> 2, p = i16 & 3;
#pragma unroll
    for (int tt = 0; tt < 4; ++tt) { const int nbu = tt >> 1, c = 4 * (tt & 1) + G; v4u o0, o1; unsigned ov[8];
#pragma unroll
        for (int j = 0; j < 4; ++j) { const int kk = 16 * c + 4 * j + q;
            const v4i16_t tr = __builtin_amdgcn_ds_read_tr16_b64_v4i16((LAS v4i16_t*)(tile + kk * 64 + (((nbu ^ c) & 1) << 5) + (p << 3)));
            const v2u tu = __builtin_bit_cast(v2u, tr); ov[2 * j] = tu.x; ov[2 * j + 1] = tu.y; }
        o0.x = ov[0]; o0.y = ov[1]; o0.z = ov[2]; o0.w = ov[3]; o1.x = ov[4]; o1.y = ov[5]; o1.z = ov[6]; o1.w = ov[7];
        bf16* dst = WT + (size_t)(n0 + 16 * nbu + i16) * K + k0 + 16 * c;
        *(v4u*)dst = o0; *(v4u*)(dst + 8) = o1; }
    asm volatile("" ::: "memory");
}
__device__ __forceinline__ void conv_items(int first, int end, int stride, const float* w1, const float* w2, unsigned char* wt1, unsigned char* wt2, LAS unsigned char* tile, int lane) {
    if (first >= end) return;
    const int n = (end - first + stride - 1) / stride;
    f32x4 va[16], vb[16]; TI64 ta, tb;
    ta = ti64_desc(first, w1, w2, wt1, wt2, lane); ti64_load(ta, va);
    int k = 1;
    while (k + 1 < n) {
        tb = ti64_desc(first + k * stride, w1, w2, wt1, wt2, lane); ti64_load(tb, vb);
        ti64_store(ta, va, tile, lane);
        ta = ti64_desc(first + (k + 1) * stride, w1, w2, wt1, wt2, lane); ti64_load(ta, va);
        ti64_store(tb, vb, tile, lane);
        k += 2;
    }
    if (k < n) { tb = ti64_desc(first + k * stride, w1, w2, wt1, wt2, lane); ti64_load(tb, vb); ti64_store(ta, va, tile, lane); ti64_store(tb, vb, tile, lane); }
    else ti64_store(ta, va, tile, lane);
}
__device__ __forceinline__ unsigned i8x4(unsigned lo2, unsigned hi2) {
    return pack_i8x4(__uint_as_float(lo2 << 16), __uint_as_float(lo2 & 0xffff0000u), __uint_as_float(hi2 << 16), __uint_as_float(hi2 & 0xffff0000u));
}
__device__ __forceinline__ void ti64_store_i8(const TI64& t, const f32x4 (&v)[16], LAS unsigned char* tile, int lane) {
    const int r8 = lane >> 3, c8 = lane & 7;
#pragma unroll
    for (int i = 0; i < 16; ++i) { const int kk = 8 * i + r8;
        v2u o; o.x = pg8::cvt_pk_bf16(v[i][0], v[i][1]); o.y = pg8::cvt_pk_bf16(v[i][2], v[i][3]);
        *(LAS v2u*)(tile + kk * 64 + ((((c8 >> 2) ^ (kk >> 4)) & 1) << 5) + ((c8 & 3) << 3)) = o; }
    asm volatile("" ::: "memory");
    const int G = lane >> 4, i16 = lane & 15, q = i16 >> 2, p = i16 & 3;
#pragma unroll
    for (int tt = 0; tt < 4; ++tt) { const int nbu = tt >> 1, c = 4 * (tt & 1) + G; v4u o; unsigned ov[4];
#pragma unroll
        for (int j = 0; j < 4; ++j) { const int kk = 16 * c + 4 * j + q;
            const v4i16_t tr = __builtin_amdgcn_ds_read_tr16_b64_v4i16((LAS v4i16_t*)(tile + kk * 64 + (((nbu ^ c) & 1) << 5) + (p << 3)));
            const v2u tu = __builtin_bit_cast(v2u, tr); ov[j] = i8x4(tu.x, tu.y); }
        o.x = ov[0]; o.y = ov[1]; o.z = ov[2]; o.w = ov[3];
        *(v4u*)(t.dst + (size_t)(16 * nbu + i16) * t.K + 16 * c) = o; }
    asm volatile("" ::: "memory");
}
__device__ __forceinline__ void wtin_block(LAS unsigned char* lds, int nb, const float* W, unsigned char* wt8, float* csc, int tid) {
    const int lane = tid & 63, wave = tid >> 6, r8 = lane >> 3, c8 = lane & 7;
    int sc[4];
#pragma unroll
    for (int q = 0; q < 4; ++q) sc[q] = proj_src_col(32 * nb + 4 * c8 + q);
    const bool contig = nb < 104;
    f32x4 v[2][16];
#pragma unroll
    for (int it = 0; it < 2; ++it)
#pragma unroll
        for (int i = 0; i < 16; ++i) { const float* rowp = W + (size_t)(128 * (2 * wave + it) + 8 * i + r8) * NPROJ;
            if (contig) v[it][i] = __builtin_nontemporal_load((const f32x4*)(rowp + sc[0]));
            else {
#pragma unroll
                for (int q = 0; q < 4; ++q) v[it][i][q] = sc[q] >= 0 ? rowp[sc[q]] : 0.f; } }
    float am[4] = {0.f, 0.f, 0.f, 0.f};
#pragma unroll
    for (int it = 0; it < 2; ++it)
#pragma unroll
        for (int i = 0; i < 16; ++i)
#pragma unroll
            for (int q = 0; q < 4; ++q) am[q] = fmaxf(am[q], fabsf(v[it][i][q]));
    LAS float* cm = (LAS float*)(lds + 131072);
#pragma unroll
    for (int q = 0; q < 4; ++q) { am[q] = fmaxf(am[q], __shfl_xor(am[q], 8)); am[q] = fmaxf(am[q], __shfl_xor(am[q], 16)); am[q] = fmaxf(am[q], __shfl_xor(am[q], 32)); }
    if (r8 == 0) {
#pragma unroll
        for (int q = 0; q < 4; ++q) cm[wave * 32 + 4 * c8 + q] = am[q]; }
    __syncthreads();
    float inv[4];
#pragma unroll
    for (int q = 0; q < 4; ++q) { float m = 0.f;
#pragma unroll
        for (int w = 0; w < 8; ++w) m = fmaxf(m, cm[w * 32 + 4 * c8 + q]);
        inv[q] = m > 0.f ? 127.0f / m : 0.f; if (wave == 0 && r8 == 0) csc[32 * nb + 4 * c8 + q] = m * (1.0f / 127.0f); }
#pragma unroll
    for (int it = 0; it < 2; ++it) {
#pragma unroll
        for (int i = 0; i < 16; ++i)
#pragma unroll
            for (int q = 0; q < 4; ++q) v[it][i][q] = rintf(v[it][i][q] * inv[q]);
        TI64 t; t.src = nullptr; t.ldw = 0; t.K = D; t.dst = wt8 + (size_t)(32 * nb) * D + 128 * (2 * wave + it);
        ti64_store_i8(t, v[it], lds + wave * 16384, lane); }
    __syncthreads();
}
struct SC_in  { __device__ int operator()(int n) const { return proj_src_col(n); } };
struct SC_uq  { __device__ int operator()(int n) const { const int h = n / DQK, d = n - h * DQK; if (d < 128) return n; const int i = d - 128; return h * DQK + 128 + (i >> 1) + 32 * (i & 1); } };
struct SC_id  { __device__ int operator()(int n) const { return n; } };
struct SC_w1  { __device__ int operator()(int n) const { const int pn = n >> 8, j = n & 255; return (j < 128) ? (128 * pn + j) : (2048 + 128 * pn + j - 128); } };

struct EpiProj { static constexpr bool PERM = true, STAGED = false;
    bf16* proj; float* ssqp; const float* rsc; const float* csc;
    __device__ __forceinline__ void operator()(const f32x4 (&acc)[2][2][4][2], const pg8::Unit& u, int wr, int wc, int fr, int fq) const {
        const int row0 = u.pm * 256 + wr * 64 + fr, col0 = u.pn * 256 + wc * 32 + 8 * fq;
#pragma unroll
        for (int ai = 0; ai < 2; ++ai)
#pragma unroll
            for (int m = 0; m < 4; ++m) { const int r = row0 + ai * 128 + m * 16; float ss = 0.f; const float rs = rsc[r];
#pragma unroll
                for (int bj = 0; bj < 2; ++bj) { const f32x4 c0 = *(const f32x4*)(csc + col0 + bj * 128), c1 = *(const f32x4*)(csc + col0 + bj * 128 + 4);
                    const f32x4 v0 = __builtin_convertvector(__builtin_bit_cast(pg8::v4i_t, acc[ai][bj][m][0]), f32x4) * c0 * rs, v1 = __builtin_convertvector(__builtin_bit_cast(pg8::v4i_t, acc[ai][bj][m][1]), f32x4) * c1 * rs;
                    v4u o; o.x = pk2(v0[0], v0[1]); o.y = pk2(v0[2], v0[3]); o.z = pk2(v1[0], v1[1]); o.w = pk2(v1[2], v1[3]);
                    *(v4u*)(proj + (size_t)r * NPROJP + col0 + bj * 128) = o;
                    ss += v0[0] * v0[0] + v0[1] * v0[1] + v0[2] * v0[2] + v0[3] * v0[3] + v1[0] * v1[0] + v1[1] * v1[1] + v1[2] * v1[2] + v1[3] * v1[3]; }
                if (u.pn < 5) { ss += __shfl_xor(ss, 16); ss += __shfl_xor(ss, 32); if (fq == 0) ssqp[(size_t)r * 20 + 4 * u.pn + wc] = ss; } }
    }
};


__device__ __forceinline__ float ssq_q_of(const float* ssqp, int r) { const f32x4* p = (const f32x4*)(ssqp + (size_t)r * 20); const f32x4 a = p[0], b = p[1], c = p[2];
    return ((a[0] + a[1]) + (a[2] + a[3])) + ((b[0] + b[1]) + (b[2] + b[3])) + ((c[0] + c[1]) + (c[2] + c[3])); }
__device__ __forceinline__ float ssq_kv_of(const float* ssqp, int r) { const f32x4* p = (const f32x4*)(ssqp + (size_t)r * 20 + 12); const f32x4 a = p[0], b = p[1];
    return ((a[0] + a[1]) + (a[2] + a[3])) + ((b[0] + b[1]) + (b[2] + b[3])); }
struct EpiQ { static constexpr bool PERM = true, STAGED = false;
    bf16* Q; const float* ssqp; const float* rope;
    __device__ __forceinline__ void operator()(const f32x4 (&acc)[2][2][4][2], const pg8::Unit& u, int wr, int wc, int fr, int fq) const {
        const int row0 = u.pm * 256 + wr * 64 + fr;
#pragma unroll
        for (int ai = 0; ai < 2; ++ai)
#pragma unroll
            for (int m = 0; m < 4; ++m) { const int r = row0 + ai * 128 + m * 16; const int b = r >> 11, s = r & 2047, pos = s + NMETA;
                const float rs = (1.0f / sqrtf(ssq_q_of(ssqp, r) * (1.f / QL) + RMS_EPS)) * QSCALE;
#pragma unroll
                for (int bj = 0; bj < 2; ++bj) { const int c0 = u.pn * 256 + bj * 128 + wc * 32 + 8 * fq; const int h = c0 / DQK, d0 = c0 - h * DQK;
                    f32x4 v0 = acc[ai][bj][m][0] * rs, v1 = acc[ai][bj][m][1] * rs;
                    if (d0 >= 128) { const f32x4* rp = (const f32x4*)(rope + (size_t)(pos * 32 + ((d0 - 128) >> 1)) * 2); const f32x4 r0 = rp[0], r1 = rp[1];
                        f32x4 w0, w1;
                        w0[0] = v0[0] * r0[0] - v0[1] * r0[1]; w0[1] = v0[1] * r0[0] + v0[0] * r0[1];
                        w0[2] = v0[2] * r0[2] - v0[3] * r0[3]; w0[3] = v0[3] * r0[2] + v0[2] * r0[3];
                        w1[0] = v1[0] * r1[0] - v1[1] * r1[1]; w1[1] = v1[1] * r1[0] + v1[0] * r1[1];
                        w1[2] = v1[2] * r1[2] - v1[3] * r1[3]; w1[3] = v1[3] * r1[2] + v1[2] * r1[3];
                        v0 = w0; v1 = w1; }
                    v4u o; o.x = pk2(v0[0], v0[1]); o.y = pk2(v0[2], v0[3]); o.z = pk2(v1[0], v1[1]); o.w = pk2(v1[2], v1[3]);
                    *(v4u*)(Q + (((size_t)b * NH + h) * S + s) * DQK + d0) = o; } }
    }
};
struct EpiKV { static constexpr bool PERM = true, STAGED = false;
    bf16* Kc; bf16* Vt; const float* ssqp; const bf16* proj; const float* rope;
    __device__ __forceinline__ void operator()(const f32x4 (&acc)[2][2][4][2], const pg8::Unit& u, int wr, int wc, int fr, int fq) const {
        const int row0 = u.pm * 256 + wr * 64 + fr;
#pragma unroll
        for (int ai = 0; ai < 2; ++ai)
#pragma unroll
            for (int m = 0; m < 4; ++m) { const int r = row0 + ai * 128 + m * 16;
                if (r < T + NMETA) {
                    const float rs = 1.0f / sqrtf(ssq_kv_of(ssqp, r) * (1.f / KVL) + RMS_EPS);
                    int b0, b1, key; if (r < T) { b0 = r >> 11; b1 = b0 + 1; key = NMETA + (r & 2047); } else { b0 = 0; b1 = NB; key = r - T; }
#pragma unroll
                    for (int bj = 0; bj < 2; ++bj) { const int c0 = u.pn * 256 + bj * 128 + wc * 32 + 8 * fq;
                        const f32x4 v0 = acc[ai][bj][m][0] * rs, v1 = acc[ai][bj][m][1] * rs;
                        const int h = c0 >> 7, d0 = c0 & 127;
                        v4u o; o.x = pk2(v0[0], v0[1]); o.y = pk2(v0[2], v0[3]); o.z = pk2(v1[0], v1[1]); o.w = pk2(v1[2], v1[3]);
                        for (int b = b0; b < b1; ++b) *(v4u*)(Kc + (((size_t)b * NH + h) * KPAD + key) * DQK + d0) = o; }
                }
            }
        if (u.pn < 4) {
#pragma unroll
            for (int ai = 0; ai < 2; ++ai) { const int r = row0 + ai * 128 + wc * 16;
                if (r < T + NMETA) {
                    int b0, b1, key; if (r < T) { b0 = r >> 11; b1 = b0 + 1; key = NMETA + (r & 2047); } else { b0 = 0; b1 = NB; key = r - T; }
                    const int h = 2 * u.pn + (fq & 1), half = fq >> 1;
                    const v4u* src = (const v4u*)(proj + (size_t)r * NPROJP + PC_KPE + 32 * half);
                    const f32x4* rp = (const f32x4*)(rope + (size_t)(key * 32 + 16 * half) * 2);
                    v4u o[4];
#pragma unroll
                    for (int q = 0; q < 4; ++q) { const v4u x = src[q]; const f32x4 ra = rp[2 * q], rb = rp[2 * q + 1];
                        const unsigned xs[4] = {x.x, x.y, x.z, x.w}; const float cs[8] = {ra[0], ra[1], ra[2], ra[3], rb[0], rb[1], rb[2], rb[3]}; unsigned ov[4];
#pragma unroll
                        for (int p = 0; p < 4; ++p) { const float x1 = __uint_as_float(xs[p] << 16), x2 = __uint_as_float(xs[p] & 0xffff0000u); const float c = cs[2 * p], sn = cs[2 * p + 1];
                            ov[p] = pk2(x1 * c - x2 * sn, x2 * c + x1 * sn); }
                        o[q].x = ov[0]; o[q].y = ov[1]; o[q].z = ov[2]; o[q].w = ov[3]; }
                    for (int b = b0; b < b1; ++b) { v4u* dst = (v4u*)(Kc + (((size_t)b * NH + h) * KPAD + key) * DQK + 128 + 32 * half);
#pragma unroll
                        for (int q = 0; q < 4; ++q) dst[q] = o[q]; }
                }
            }
        }
    }
};

struct EpiVt { static constexpr bool PERM = true, STAGED = false;
    bf16* Vt; const float* ssqp;
    __device__ __forceinline__ void operator()(const f32x4 (&acc)[2][2][4][2], const pg8::Unit& u, int wr, int wc, int fr, int fq) const {
#pragma unroll
        for (int ai = 0; ai < 2; ++ai)
#pragma unroll
            for (int m = 0; m < 4; ++m) { const int r0 = u.pm * 256 + ai * 128 + wr * 64 + m * 16 + 4 * fq;
                if (r0 < T + NMETA) {
                    f32x4 rs;
#pragma unroll
                    for (int j = 0; j < 4; ++j) rs[j] = 1.0f / sqrtf(ssq_kv_of(ssqp, r0 + j) * (1.f / KVL) + RMS_EPS);
                    int b0, b1, key; if (r0 < T) { b0 = r0 >> 11; b1 = b0 + 1; key = NMETA + (r0 & 2047); } else { b0 = 0; b1 = NB; key = r0 - T; }
                    const int kp = keypos(key);
#pragma unroll
                    for (int bj = 0; bj < 2; ++bj)
#pragma unroll
                        for (int n = 0; n < 2; ++n) { const int cv = u.pn * 256 + bj * 128 + wc * 32 + 8 * (fr >> 2) + 4 * n + (fr & 3); const int h = cv >> 7, d = cv & 127;
                            const f32x4 v = acc[ai][bj][m][n] * rs; v2u o; o.x = pk2(v[0], v[1]); o.y = pk2(v[2], v[3]);
                            for (int b = b0; b < b1; ++b) *(v2u*)(Vt + (((size_t)b * NH + h) * DV + d) * KPAD + kp) = o; }
                }
            }
    }
};

constexpr int CT = 32, CROWS = CT + 30;
__device__ __forceinline__ void conv_unit(LAS unsigned char* lds, int unit, const bf16* proj, const float* dw_w, const float* dw_b, const float* ln_g, const float* ln_b, unsigned char* mix) {
    int tid = my_tid(); asm volatile("" : "+v"(tid));
    const int lane = tid & 63, wave = tid >> 6;
    const int b = unit / (S / CT), s0 = (unit % (S / CT)) * CT, p0 = s0 + NMETA;
    LAS unsigned char* glu = lds; LAS float* red = (LAS float*)(lds + CROWS * 2048);
#pragma unroll 4
    for (int idx = tid; idx < CROWS * 128; idx += NTHR) { const int row = idx >> 7, c8 = idx & 127; const int j = p0 - 30 + row;
        v4u o = {0u, 0u, 0u, 0u};
        if (j >= 0) { const int srow = (j < NMETA) ? (T + j) : (b * S + j - NMETA);
            const v4u a = *(const v4u*)(proj + (size_t)srow * NPROJP + PC_A + 8 * c8), g = *(const v4u*)(proj + (size_t)srow * NPROJP + PC_G + 8 * c8);
            const unsigned av[4] = {a.x, a.y, a.z, a.w}, gv[4] = {g.x, g.y, g.z, g.w}; unsigned ov[4];
#pragma unroll
            for (int p = 0; p < 4; ++p) { const float a0 = __uint_as_float(av[p] << 16), a1 = __uint_as_float(av[p] & 0xffff0000u), g0 = __uint_as_float(gv[p] << 16), g1 = __uint_as_float(gv[p] & 0xffff0000u);
                ov[p] = pk2(a0 * __builtin_amdgcn_rcpf(1.0f + __expf(-g0)), a1 * __builtin_amdgcn_rcpf(1.0f + __expf(-g1))); }
            o.x = ov[0]; o.y = ov[1]; o.z = ov[2]; o.w = ov[3]; }
        *(LAS v4u*)(glu + row * 2048 + c8 * 16) = o; }
    __syncthreads();
    float w0[CW], w1[CW];
#pragma unroll
    for (int w = 0; w < CW; ++w) { const float2 ww = *(const float2*)(dw_w + w * CC + 2 * tid); w0[w] = ww.x; w1[w] = ww.y; }
#pragma unroll
    for (int hf = 0; hf < CT / 16; ++hf) {
        float acc0[16], acc1[16];
        { const float2 bb = *(const float2*)(dw_b + 2 * tid);
#pragma unroll
          for (int t = 0; t < 16; ++t) { acc0[t] = bb.x; acc1[t] = bb.y; } }
        const LAS unsigned char* gl = glu + hf * 16 * 2048;
#pragma unroll
        for (int j = 0; j < 46; ++j) { if ((j & 7) == 0) __builtin_amdgcn_sched_barrier(0);
            const unsigned xv = *(const LAS unsigned*)(gl + j * 2048 + tid * 4); const float x0 = __uint_as_float(xv << 16), x1 = __uint_as_float(xv & 0xffff0000u);
#pragma unroll
            for (int t = 0; t < 16; ++t) { const int w = j - t; if (w >= 0 && w < CW) { acc0[t] += x0 * w0[w]; acc1[t] += x1 * w1[w]; } } }
#pragma unroll
        for (int t = 0; t < 16; ++t) { const float p = wave_sum(acc0[t] + acc1[t]); if (lane == 0) red[t * 8 + wave] = p; }
        __syncthreads();
#pragma unroll
        for (int t = 0; t < 16; ++t) { float sum = 0.f;
#pragma unroll
            for (int w = 0; w < 8; ++w) sum += red[t * 8 + w];
            const float mean = sum * (1.f / CC); acc0[t] -= mean; acc1[t] -= mean; }
#pragma unroll
        for (int t = 0; t < 16; ++t) { const float p = wave_sum(acc0[t] * acc0[t] + acc1[t] * acc1[t]); if (lane == 0) red[128 + t * 8 + wave] = p; }
        __syncthreads();
        const float2 gg = *(const float2*)(ln_g + 2 * tid), bb2 = *(const float2*)(ln_b + 2 * tid);
#pragma unroll
        for (int t = 0; t < 16; ++t) { float sum = 0.f;
#pragma unroll
            for (int w = 0; w < 8; ++w) sum += red[128 + t * 8 + w];
            const float rstd = 1.0f / sqrtf(sum * (1.f / CC) + LN_EPS);
            const float y0 = acc0[t] * rstd * gg.x + bb2.x, y1 = acc1[t] * rstd * gg.y + bb2.y;
            *(unsigned short*)(mix + (size_t)(b * S + s0 + 16 * hf + t) * D + CC + 2 * tid) = (unsigned short)__builtin_amdgcn_cvt_pk_fp8_f32(MIX_S * y0 * __builtin_amdgcn_rcpf(1.0f + __expf(-y0)), MIX_S * y1 * __builtin_amdgcn_rcpf(1.0f + __expf(-y1)), 0, false); }
        __syncthreads();
    }
}

constexpr int ATT_KB = 64 * DQK * 2, ATT_VB = DV * 64 * 2, ATT_VOFF = 2 * ATT_KB;
__device__ __forceinline__ void attn_block(LAS unsigned char* lds, const bf16* Q, const bf16* Kc, const bf16* Vt, unsigned char* mix, int b, int h, int qb) {
    int tid = my_tid(); asm volatile("" : "+v"(tid));
    const int lane = tid & 63, wave = __builtin_amdgcn_readfirstlane(tid >> 6), ql = lane & 15, g = lane >> 4;
    const int s = qb * 128 + wave * 16 + ql, pos = s + NMETA;
    const int pos_lo = qb * 128 + wave * 16 + NMETA, pos_hi = pos_lo + 15;
    bf16x8 qf[6];
    { const bf16* qp = Q + (((size_t)b * NH + h) * S + s) * DQK + 8 * g;
#pragma unroll
      for (int ks = 0; ks < 6; ++ks) qf[ks] = *(const bf16x8*)(qp + 32 * ks); }
    const unsigned char* kbase = (const unsigned char*)(Kc + ((size_t)b * NH + h) * KPAD * DQK);
    const unsigned char* vbase = (const unsigned char*)(Vt + ((size_t)b * NH + h) * DV * KPAD);
    const int nt = 2 * qb + 3;
    unsigned kl[3], vl[2], vg[2];
#pragma unroll
    for (int i = 0; i < 3; ++i) { const int id = tid + 512 * i, row = id / 24, ch = id - row * 24; kl[i] = row * 384 + (((ch & ~7) | ((ch ^ (row >> 1)) & 7)) << 4); }
#pragma unroll
    for (int i = 0; i < 2; ++i) { const int id = tid + 512 * i, d = id >> 3, ch = id & 7; vl[i] = d * 128 + (((ch ^ (d >> 1)) & 7) << 4); vg[i] = d * (KPAD * 2) + ch * 16; }
    v4u kr[3], vr[2];
#define ATT_LOAD(t) do { _Pragma("unroll") for (int i = 0; i < 3; ++i) kr[i] = *(const v4u*)(kbase + (size_t)(t) * ATT_KB + (size_t)(tid + 512 * i) * 16); \
                         _Pragma("unroll") for (int i = 0; i < 2; ++i) vr[i] = *(const v4u*)(vbase + (size_t)(t) * 128 + vg[i]); } while (0)
#define ATT_WRITE(buf) do { _Pragma("unroll") for (int i = 0; i < 3; ++i) *(LAS v4u*)(lds + (buf) * ATT_KB + kl[i]) = kr[i]; \
                            _Pragma("unroll") for (int i = 0; i < 2; ++i) *(LAS v4u*)(lds + ATT_VOFF + (buf) * ATT_VB + vl[i]) = vr[i]; } while (0)
    const int x = (ql >> 1) & 7;
    const unsigned kb0 = ql * 384 + ((g ^ x) << 4), kb1 = kb0 ^ 64u;
    const unsigned vb0 = ql * 128 + ((g ^ x) << 4), vb1 = vb0 ^ 64u;
    f32x4 o[8];
#pragma unroll
    for (int i = 0; i < 8; ++i) o[i] = (f32x4){0.f, 0.f, 0.f, 0.f};
    float m_run = -1e30f, l_run = 0.f;
    ATT_LOAD(0); ATT_WRITE(0);
    __syncthreads();
    for (int t = 0; t < nt; ++t) {
        const int buf = t & 1;
        if (t + 1 < nt) ATT_LOAD(t + 1);
        if (64 * t <= pos_hi) {
            const LAS unsigned char* kt = lds + buf * ATT_KB; const LAS unsigned char* vt = lds + ATT_VOFF + buf * ATT_VB;
            f32x4 sc[4];
#pragma unroll
            for (int kb = 0; kb < 4; ++kb) { sc[kb] = (f32x4){0.f, 0.f, 0.f, 0.f};
#pragma unroll
                for (int ks = 0; ks < 6; ++ks) { const bf16x8 kf = *(const LAS bf16x8*)(kt + ((ks & 1) ? kb1 : kb0) + kb * 6144 + (ks >> 1) * 128);
                    sc[kb] = __builtin_amdgcn_mfma_f32_16x16x32_bf16(kf, qf[ks], sc[kb], 0, 0, 0); } }
            bf16x8 vf[4][2];
#pragma unroll
            for (int db = 0; db < 4; ++db)
#pragma unroll
                for (int k2 = 0; k2 < 2; ++k2) vf[db][k2] = *(const LAS bf16x8*)(vt + (k2 ? vb1 : vb0) + db * 2048);
            if (64 * t + 63 > pos_lo) {
#pragma unroll
                for (int kb = 0; kb < 4; ++kb)
#pragma unroll
                    for (int r = 0; r < 4; ++r) if (64 * t + 16 * kb + 4 * g + r > pos) sc[kb][r] = -1e30f;
            }
            float mx = sc[0][0];
#pragma unroll
            for (int kb = 0; kb < 4; ++kb)
#pragma unroll
                for (int r = 0; r < 4; ++r) mx = fmaxf(mx, sc[kb][r]);
            mx = fmaxf(mx, __shfl_xor(mx, 16)); mx = fmaxf(mx, __shfl_xor(mx, 32));
            const float m_new = fmaxf(m_run, mx);
            const float alpha = __builtin_amdgcn_exp2f(m_run - m_new);
            m_run = m_new;
            float ps = 0.f;
#pragma unroll
            for (int kb = 0; kb < 4; ++kb)
#pragma unroll
                for (int r = 0; r < 4; ++r) { sc[kb][r] = __builtin_amdgcn_exp2f(sc[kb][r] - m_new); ps += sc[kb][r]; }
            l_run = l_run * alpha + ps;
#pragma unroll
            for (int i = 0; i < 8; ++i) o[i] = o[i] * alpha;
            union { v4u u; bf16x8 v; } pf[2];
#pragma unroll
            for (int k2 = 0; k2 < 2; ++k2) { pf[k2].u.x = pg8::cvt_pk_bf16(sc[2 * k2][0], sc[2 * k2][1]); pf[k2].u.y = pg8::cvt_pk_bf16(sc[2 * k2][2], sc[2 * k2][3]);
                pf[k2].u.z = pg8::cvt_pk_bf16(sc[2 * k2 + 1][0], sc[2 * k2 + 1][1]); pf[k2].u.w = pg8::cvt_pk_bf16(sc[2 * k2 + 1][2], sc[2 * k2 + 1][3]); }
#pragma unroll
            for (int db = 0; db < 8; ++db)
#pragma unroll
                for (int k2 = 0; k2 < 2; ++k2) { const bf16x8 vq = (db < 4) ? vf[db & 3][k2] : *(const LAS bf16x8*)(vt + (k2 ? vb1 : vb0) + db * 2048);
                    o[db] = __builtin_amdgcn_mfma_f32_16x16x32_bf16(vq, pf[k2].v, o[db], 0, 0, 0); }
        }
        if (t + 1 < nt) ATT_WRITE(buf ^ 1);
        __syncthreads();
    }
#undef ATT_LOAD
#undef ATT_WRITE
    float l = l_run; l += __shfl_xor(l, 16); l += __shfl_xor(l, 32);
    const float inv = MIX_S / l;
    unsigned char* op = mix + (size_t)(b * S + s) * D + h * DV + 4 * g;
#pragma unroll
    for (int db = 0; db < 8; ++db) { int w = __builtin_amdgcn_cvt_pk_fp8_f32(o[db][0] * inv, o[db][1] * inv, 0, false); w = __builtin_amdgcn_cvt_pk_fp8_f32(o[db][2] * inv, o[db][3] * inv, w, true);
        *(int*)(op + 16 * db) = w; }
}


struct EpiRes { static constexpr bool PERM = false, STAGED = false;
    float* x1; const float* x; const float* lnstat; const float* g; const float* b;
    __device__ __forceinline__ void operator()(const f32x4 (&acc)[2][2][4][2], const pg8::Unit& u, int wr, int wc, int fr, int fq) const {
        const int row0 = u.pm * 256 + wr * 64 + fr, col0 = u.pn * 256 + wc * 32 + 4 * fq;
#pragma unroll
        for (int ai = 0; ai < 2; ++ai)
#pragma unroll
            for (int m = 0; m < 4; ++m) { const int r = row0 + ai * 128 + m * 16; const size_t off = (size_t)r * D + col0;
                const float mean = lnstat[2 * r], rstd = lnstat[2 * r + 1];
#pragma unroll
                for (int bj = 0; bj < 2; ++bj)
#pragma unroll
                    for (int n = 0; n < 2; ++n) { const int c = col0 + bj * 128 + n * 16; const f32x4 xv = *(const f32x4*)(x + off + bj * 128 + n * 16), gg = *(const f32x4*)(g + c), bb = *(const f32x4*)(b + c);
                        const f32x4 hv = (xv - mean) * rstd * gg + bb; *(f32x4*)(x1 + off + bj * 128 + n * 16) = hv * ALPHA + acc[ai][bj][m][n] * (1.0f / (MIX_S * F8_SW)); } }
    }
};
struct EpiSwiglu { static constexpr bool PERM = true, STAGED = false;
    unsigned char* act; const float* b1;
    __device__ __forceinline__ void operator()(const f32x4 (&acc)[2][2][4][2], const pg8::Unit& u, int wr, int wc, int fr, int fq) const {
        const int e = u.pm >> 5, pnl = u.pn & 15; const int row0 = u.pm * 256 + wr * 64 + fr, col0 = 128 * pnl + wc * 32 + 8 * fq;
        const float* bg = b1 + (size_t)e * 4096 + col0; const float* bu = bg + 2048;
        const f32x4 bg0 = *(const f32x4*)bg, bg1 = *(const f32x4*)(bg + 4), bu0 = *(const f32x4*)bu, bu1 = *(const f32x4*)(bu + 4);
#pragma unroll
        for (int ai = 0; ai < 2; ++ai)
#pragma unroll
            for (int m = 0; m < 4; ++m) { float a[8];
#pragma unroll
                for (int n = 0; n < 2; ++n)
#pragma unroll
                    for (int j = 0; j < 4; ++j) { float gv = acc[ai][0][m][n][j] * F8_INV + (n ? bg1[j] : bg0[j]), uv = acc[ai][1][m][n][j] * F8_INV + (n ? bu1[j] : bu0[j]);
                        gv = fminf(gv, SW_LIMIT); uv = fminf(fmaxf(uv, -SW_LIMIT), SW_LIMIT);
                        a[4 * n + j] = (F8_SX * gv) * (uv + 1.0f) * __builtin_amdgcn_rcpf(1.0f + __builtin_amdgcn_exp2f(-SW_ALPHA * 1.4426950408889634f * gv)); }
                int w0 = __builtin_amdgcn_cvt_pk_fp8_f32(a[0], a[1], 0, false); w0 = __builtin_amdgcn_cvt_pk_fp8_f32(a[2], a[3], w0, true);
                int w1 = __builtin_amdgcn_cvt_pk_fp8_f32(a[4], a[5], 0, false); w1 = __builtin_amdgcn_cvt_pk_fp8_f32(a[6], a[7], w1, true);
                v2u o; o.x = (unsigned)w0; o.y = (unsigned)w1;
                *(v2u*)(act + (size_t)(row0 + ai * 128 + m * 16) * DFF + col0) = o; }
    }
};
constexpr int STG_OFF = 131072, STG_BIAS = 17408;
struct EpiEo { static constexpr bool PERM = true, STAGED = true;
    unsigned char* eo; const float* b2; LAS unsigned char* stg;
    __device__ __forceinline__ void pre(const pg8::Unit& u, int ui, int wid, int lane) const {
        if (wid == 0) { const int e = u.pm >> 5, pnl = u.pn & 7;
            __builtin_amdgcn_global_load_lds((const unsigned*)(b2 + (size_t)e * D + 256 * pnl + 4 * lane), (LAS unsigned*)(stg + STG_BIAS + (ui & 1) * 1024), 16, 0, 0); }
    }
    __device__ __forceinline__ void run(const f32x4 (&acc)[2][2][4][2], const pg8::Unit& u, int wr, int wc, int fr, int fq, int tid, int ui) const {
        const int pnl = u.pn & 7;
        const LAS float* bl = (const LAS float*)(stg + STG_BIAS + (ui & 1) * 1024) + wc * 32 + 8 * fq;
        f32x4 bv[2][2];
#pragma unroll
        for (int bj = 0; bj < 2; ++bj)
#pragma unroll
            for (int n = 0; n < 2; ++n) bv[bj][n] = *(const LAS f32x4*)(bl + 128 * bj + 4 * n);
        LAS unsigned char* wp = stg + (32 * wr + fr) * 264 + 32 * wc + 8 * fq;
#pragma unroll
        for (int ai = 0; ai < 2; ++ai)
#pragma unroll
            for (int mp = 0; mp < 2; ++mp) {
#pragma unroll
                for (int mm = 0; mm < 2; ++mm)
#pragma unroll
                    for (int bj = 0; bj < 2; ++bj) { const int m = 2 * mp + mm; const f32x4 v0 = acc[ai][bj][m][0] * F8_INV + bv[bj][0], v1 = acc[ai][bj][m][1] * F8_INV + bv[bj][1];
                        s16x2_t r0 = {0, 0}, r1 = {0, 0};
                        r0 = __builtin_amdgcn_cvt_scalef32_pk_fp8_f32(r0, v0[0], v0[1], 1.0f / F8_SE, false); r0 = __builtin_amdgcn_cvt_scalef32_pk_fp8_f32(r0, v0[2], v0[3], 1.0f / F8_SE, true);
                        r1 = __builtin_amdgcn_cvt_scalef32_pk_fp8_f32(r1, v1[0], v1[1], 1.0f / F8_SE, false); r1 = __builtin_amdgcn_cvt_scalef32_pk_fp8_f32(r1, v1[2], v1[3], 1.0f / F8_SE, true);
                        v2u o; o.x = __builtin_bit_cast(unsigned, r0); o.y = __builtin_bit_cast(unsigned, r1);
                        *(LAS v2u*)(wp + 16 * mm * 264 + 128 * bj) = o; }
                LDS_WAIT(); __builtin_amdgcn_s_barrier();
#pragma unroll
                for (int j = 0; j < 2; ++j) { const int p = tid + 512 * j, rl = p >> 4, c16 = p & 15;
                    const v2u lo = *(const LAS v2u*)(stg + rl * 264 + 16 * c16), hi = *(const LAS v2u*)(stg + rl * 264 + 16 * c16 + 8);
                    v4u o4; o4.x = lo.x; o4.y = lo.y; o4.z = hi.x; o4.w = hi.y;
                    const int grow = u.pm * 256 + 128 * ai + 64 * (rl >> 5) + 16 * (2 * mp + ((rl >> 4) & 1)) + (rl & 15);
                    *(v4u*)(eo + (size_t)grow * D + 256 * pnl + 16 * c16) = o4; }
                if (!(ai == 1 && mp == 1)) { LDS_WAIT(); __builtin_amdgcn_s_barrier(); }
            }
    }
};
struct MoeOrder {
    const LAS int* pre; int G, c, NT, ioff, icnt;
    __device__ bool next(int i, pg8::Unit& u) const {
        if (i >= icnt) return false;
        const int L = (i + ioff) * G + c; if (L >= pre[NE]) return false;
        int e = 0; while (pre[e + 1] <= L) ++e;
        const int idx = L - pre[e], te = (pre[e + 1] - pre[e]) / NT; const int pn = idx / te, mt = idx - pn * te;
        u.pm = e * (CAP / 256) + mt; u.pn = e * NT + pn; return true;
    }
};

constexpr int HS = 2052;
__device__ __forceinline__ void ln1_router_unit(LAS unsigned char* lds, int unit, const float* x1, const float* g1, const float* b1n, const float* wr_, const float* br_,
                                                bf16* h1b, unsigned char* xg, int* cnt, int* r_e, float* r_g, int* r_pos) {
    int tid = my_tid(); asm volatile("" : "+v"(tid));
    const int lane = tid & 63, wave = __builtin_amdgcn_readfirstlane(tid >> 6);
    LAS float* hbuf = (LAS float*)lds; LAS float* part = hbuf + 16 * HS; LAS float* logits = part + 8 * 512;
    LAS int* sel = (LAS int*)(logits + 512); LAS int* rank = sel + 64; LAS int* base = rank + 64;
#pragma unroll 1
    for (int rr = 0; rr < 2; ++rr) { const int rl = 2 * wave + rr; const size_t r = (size_t)unit * 16 + rl;
        f32x4 v[8]; float s = 0.f;
#pragma unroll
        for (int j = 0; j < 8; ++j) { v[j] = *(const f32x4*)(x1 + r * D + 4 * lane + 256 * j); s += (v[j][0] + v[j][1]) + (v[j][2] + v[j][3]); }
        const float mean = wave_sum(s) * (1.f / D); float s2 = 0.f;
#pragma unroll
        for (int j = 0; j < 8; ++j) { v[j] = v[j] - mean; s2 += (v[j][0] * v[j][0] + v[j][1] * v[j][1]) + (v[j][2] * v[j][2] + v[j][3] * v[j][3]); }
        const float rstd = 1.0f / sqrtf(wave_sum(s2) * (1.f / D) + LN_EPS);
#pragma unroll
        for (int j = 0; j < 8; ++j) { const int c = 4 * lane + 256 * j; const f32x4 gg = *(const f32x4*)(g1 + c), bb = *(const f32x4*)(b1n + c);
            const f32x4 y = v[j] * rstd * gg + bb; v2u hb; hb.x = pk2(y[0], y[1]); hb.y = pk2(y[2], y[3]); *(v2u*)(h1b + r * D + c) = hb; *(LAS f32x4*)(hbuf + rl * HS + c) = y; } }
    __syncthreads();
    { const int e15 = lane & 15, kq = lane >> 4; f32x4 a0 = {0.f, 0.f, 0.f, 0.f}, a1 = {0.f, 0.f, 0.f, 0.f};
      const LAS float* hp = hbuf + e15 * HS + 256 * wave + kq; const float* wp = wr_ + (size_t)(256 * wave + kq) * NE + e15;
#pragma unroll 8
      for (int ks = 0; ks < 64; ++ks) { const float av = hp[4 * ks]; const float w0 = wp[(size_t)ks * 4 * NE], w1 = wp[(size_t)ks * 4 * NE + 16];
          a0 = __builtin_amdgcn_mfma_f32_16x16x4f32(av, w0, a0, 0, 0, 0); a1 = __builtin_amdgcn_mfma_f32_16x16x4f32(av, w1, a1, 0, 0, 0); }
#pragma unroll
      for (int q = 0; q < 4; ++q) { part[wave * 512 + (4 * kq + q) * 32 + e15] = a0[q]; part[wave * 512 + (4 * kq + q) * 32 + 16 + e15] = a1[q]; } }
    __syncthreads();
    { float sum = br_[tid & 31];
#pragma unroll
      for (int w = 0; w < 8; ++w) sum += part[w * 512 + tid];
      logits[tid] = sum; }
    __syncthreads();
#pragma unroll 1
    for (int rr = 0; rr < 2; ++rr) { const int rl = 2 * wave + rr; const int r = unit * 16 + rl;
        float val = (lane < NE) ? logits[rl * 32 + (lane & 31)] : -3.0e38f;
        int te[4]; float tv[4];
#pragma unroll
        for (int k = 0; k < 4; ++k) { float m = val;
#pragma unroll
            for (int o = 1; o < 64; o <<= 1) m = fmaxf(m, __shfl_xor(m, o));
            const unsigned long long mask = __ballot(val == m && lane < NE);
            const int e = __ffsll((long long)mask) - 1;
            te[k] = e; tv[k] = m; if (lane == e) val = -3.0e38f; }
        float ex[4], se = 0.f;
#pragma unroll
        for (int k = 0; k < 4; ++k) { ex[k] = expf(tv[k] - tv[0]); se += ex[k]; }
        if (lane == 0) { const float ise = 1.0f / se;
#pragma unroll
            for (int k = 0; k < 4; ++k) { r_e[r * 4 + k] = te[k]; r_g[r * 4 + k] = ex[k] * ise; sel[rl * 4 + k] = te[k]; } } }
    __syncthreads();
    if (wave == 0) { int count = 0;
        for (int i = 0; i < 64; ++i) { const int s_ = sel[i]; if (s_ == lane) { rank[i] = count; ++count; } }
        int bse = 0; if (lane < NE && count > 0) bse = atomicAdd(&cnt[lane * 64], count);
        if (lane < NE) base[lane] = bse; }
    __syncthreads();
#pragma unroll 1
    for (int rr = 0; rr < 2; ++rr) { const int rl = 2 * wave + rr; const int r = unit * 16 + rl;
        int te[4], pos[4];
#pragma unroll
        for (int k = 0; k < 4; ++k) { te[k] = sel[rl * 4 + k]; pos[k] = base[te[k]] + rank[rl * 4 + k]; }
        if (lane == 0) {
#pragma unroll
            for (int k = 0; k < 4; ++k) r_pos[r * 4 + k] = pos[k]; }
#pragma unroll
        for (int j = 0; j < 2; ++j) { const int c = 16 * (lane + 64 * j); v4u o; unsigned ov[4];
#pragma unroll
            for (int q = 0; q < 4; ++q) { const f32x4 y = *(const LAS f32x4*)(hbuf + rl * HS + c + 4 * q) * F8_SX;
                int w = __builtin_amdgcn_cvt_pk_fp8_f32(y[0], y[1], 0, false); w = __builtin_amdgcn_cvt_pk_fp8_f32(y[2], y[3], w, true); ov[q] = (unsigned)w; }
            o.x = ov[0]; o.y = ov[1]; o.z = ov[2]; o.w = ov[3];
#pragma unroll
            for (int k = 0; k < 4; ++k) *(v4u*)(xg + ((size_t)te[k] * CAP + pos[k]) * D + c) = o; } }
    __syncthreads();
}

__device__ __forceinline__ void moe_prefix(LAS int* pre, const int* cnt, int NT, int elo, int ehi, int tid) {
    if (tid < 64) { int nt = 0;
        if (tid < NE && tid >= elo && tid < ehi) nt = ((__hip_atomic_load(&cnt[tid * 64], __ATOMIC_RELAXED, __HIP_MEMORY_SCOPE_AGENT) + 255) >> 8) * NT;
        int incl = nt;
#pragma unroll
        for (int o = 1; o < 32; o <<= 1) { const int t = __shfl_up(incl, o); if (tid >= o) incl += t; }
        if (tid < NE) pre[tid] = incl - nt;
        if (tid == NE - 1) pre[NE] = incl; }
}

__global__ void __launch_bounds__(NTHR, 2) mk_fwd(Args args) {
    LAS unsigned char* lds = (LAS unsigned char*)lds_raw;
    volatile LAS unsigned* MISC = (volatile LAS unsigned*)(lds + MISC_OFF);
    for (int u = threadIdx.x; u < (LDS_BYTES - MISC_OFF) / 4; u += NTHR) ((LAS unsigned*)(lds + MISC_OFF))[u] = 0u;
    __syncthreads();
    if ((threadIdx.x & 63) == 0) ((LAS int*)(lds + TIDTAB_OFF))[hw_slot()] = threadIdx.x >> 6;
    __syncthreads();
    const int wave = __builtin_amdgcn_readfirstlane(my_tid() >> 6);
    const int G = gridDim.x; const int bx = blockIdx.x; const int vcu = (G % 8 == 0) ? (bx % 8) * (G / 8) + bx / 8 : bx;
    unsigned char* ws = args.ws;
    unsigned* ctl = (unsigned*)(ws + WS_CTL);
    const int lo = args.ph_lo, hi = args.ph_hi;
    const bool multi = (hi - lo) > 1;
    XcdBarrier bar; bar.bar = ctl + CW_BAR; bar.x = 0; bar.st = nullptr;
    if (multi) bar = xcd_barrier_post(ctl + CW_BAR, MISC + 8);
#define IN(k) (lo <= (k) && (k) < hi)
#define SEAM(k) do { if (IN(k) && IN((k) + 1)) xcd_barrier(bar); } while (0)
    bf16* wt_uq = (bf16*)(ws + WS_WTUQ); bf16* wt_kv = (bf16*)(ws + WS_WTKV); bf16* wt_out = (bf16*)(ws + WS_WTOUT);
    unsigned char* h0b8 = ws + WS_H0B; unsigned char* wt_in8 = ws + WS_WTIN; float* rsc = (float*)(ws + WS_RSC); float* csc = (float*)(ws + WS_CSC); bf16* proj = (bf16*)(ws + WS_PROJ);
    float* rope = (float*)(ws + WS_ROPE);
    float* ssqp = (float*)(ws + WS_SSQP); float* lnstat = (float*)(ctl + CW_LNSTAT);
    const int gw = vcu * NWAVES + wave, NGW = G * NWAVES;
    const int cvA = (G == 256) ? CONV_P1 : 0, cvB = cvA + CONV_P3_PER_WAVE * NGW, cvC = cvB + CONV_P2_PER_WAVE * NGW, cvD = cvC + CONV_P4_PER_WAVE * NGW, cvE = cvD + CONV_P5_PER_WAVE * NGW;
#define HOST_CONV(lo, hi) do { __syncthreads(); conv_items((lo) + gw, (hi), NGW, args.in[19], args.in[21], ws + WS_WT1, ws + WS_WT2, lds + wave * 16384, my_lane()); __syncthreads(); } while (0)
    const unsigned hslot = (((unsigned)vcu * 2654435761u) >> 11);

    if (IN(0)) {
        const int lane = my_lane(), tid = wave * 64 + lane;
        LAS float* scr = (LAS float*)(lds + wave * 16384);
        constexpr int F_UQ = 32 * (QL / 128), F_KV = 64 * (KVL / 128), F_OUT = 64 * (D / 128), NFAST = F_UQ + F_KV + F_OUT;
        constexpr int S_UQ = 16 * (QL / 64), NSLOW = S_UQ;
        LAS unsigned char* dtile = lds + wave * 16384;
        for (int nbk = vcu; nbk < NPROJP / 32; nbk += G) wtin_block(lds, nbk, args.in[4], wt_in8, csc, tid);
        const int gw2 = (G > NPROJP / 32) ? ((vcu + G - NPROJP / 32) % G) * NWAVES + wave : gw;
        for (int it = gw2; it < NFAST + NSLOW; it += NGW) {
            int r = it;
            if (r < F_UQ) { const int nbq = r % 32, kb = r / 32; const int col = (nbq >> 2) * DQK + 32 * (nbq & 3); tb16_item(args.in[6], 1536, QL, wt_uq, col, col, 128 * kb, args.in[5], dtile, lane); continue; } r -= F_UQ;
            if (r < F_KV) { const int nb = r % 64, kb = r / 64;
                if (nb < 32) tb16_item(args.in[8], 1024, KVL, wt_kv, 32 * nb, 32 * nb, 128 * kb, args.in[7], dtile, lane);
                else tb16_item(args.in[9], 1024, KVL, wt_kv + (size_t)1024 * KVL, 32 * (nb - 32), 32 * (nb - 32), 128 * kb, args.in[7], dtile, lane);
                continue; } r -= F_KV;
            if (r < F_OUT) { const int nb = r % 64, kb = r / 64;
                TI64 t; t.ldw = D; t.K = D; t.src = args.in[14] + (size_t)(128 * kb + (lane >> 3)) * D + 32 * nb + 4 * (lane & 7); t.dst = (unsigned char*)wt_out + (size_t)(32 * nb) * D + 128 * kb;
                f32x4 v[16]; ti64_load(t, v); ti64_store(t, v, dtile, lane); continue; } r -= F_OUT;
            { const int j = r & 15, kb = r >> 4; const int n0 = (j >> 1) * DQK + 128 + 32 * (j & 1); transpose_item(args.in[6], 1536, QL, wt_uq, n0, 64 * kb, SC_uq{}, args.in[5], scr, lane); }
        }
        {
            unsigned char* wt1 = ws + WS_WT1; unsigned char* wt2 = ws + WS_WT2;
            constexpr int NIT = NE * ((D / 128) * (4096 / 32) + (DFF / 128) * (D / 32));
            LAS unsigned char* tile = lds + wave * 16384;
            conv_items(cvE + gw2, CONV_W2, NGW, args.in[19], args.in[21], wt1, wt2, tile, lane);
        }
        for (int r = gw; r < MROWS; r += NGW) {
            if (r < T) ln_row8(args.in[0] + (size_t)r * D, args.in[2], args.in[3], lnstat + 2 * r, h0b8 + (size_t)r * D, rsc + r, lane);
            else if (r < T + NMETA) ln_row8(args.in[1] + (size_t)(r - T) * D, args.in[2], args.in[3], nullptr, h0b8 + (size_t)r * D, rsc + r, lane);
            else { if (lane == 0) rsc[r] = 0.f;
#pragma unroll
                for (int j = 0; j < 8; ++j) *(unsigned*)(h0b8 + (size_t)r * D + 4 * lane + 256 * j) = 0u; }
        }
        for (int idx = (bx * NTHR + tid); idx < LSEQ * 32; idx += G * NTHR) {
            const int pos = idx / 32, i = idx % 32;
            const float inv = 1.0f / powf(10000.0f, (float)(2 * i) / 64.0f);
            const float f = (float)pos * inv;
            rope[2 * idx] = (float)cos((double)f); rope[2 * idx + 1] = (float)sin((double)f);
        }
    }
    SEAM(0);
    if (IN(1)) {
        pg8::Gemm g{(const bf16*)h0b8, (const bf16*)wt_in8, D / 2, D / 2, D / 2}; pg8::StaticOrder S; S.init(MROWS / 256, NPROJP / 256, G, bx);
        EpiProj E{proj, ssqp, rsc, csc};
        pg8::gemm_phase<EpiProj, pg8::StaticOrder, true, true, false, false, true>(lds, g, S, E);
        if (G == 256 && bx >= 206) {
            __syncthreads();
            conv_items((bx - 206) * NWAVES + wave, CONV_P1, 50 * NWAVES, args.in[19], args.in[21], ws + WS_WT1, ws + WS_WT2, lds + wave * 16384, my_lane());
        }
    }
    SEAM(1);
    if (IN(2)) {
        bf16* Q = (bf16*)(ws + WS_Q); bf16* Kc = (bf16*)(ws + WS_K); bf16* Vt = (bf16*)(ws + WS_V); unsigned char* mix = ws + WS_MIX;
        const unsigned s2 = hslot % 4u;
        if (s2 == 0) HOST_CONV(cvB, cvC);
        { pg8::Gemm g{proj + PC_Q, wt_uq, QL, NPROJP, QL}; pg8::StaticOrder S; S.init(T / 256, 1536 / 256, G, bx);
          EpiQ E{Q, ssqp, rope};
          pg8::gemm_phase<EpiQ, pg8::StaticOrder, true, true>(lds, g, S, E); }
        if (s2 == 1) HOST_CONV(cvB, cvC);
        { pg8::Gemm g{proj + PC_KV, wt_kv, KVL, NPROJP, KVL}; pg8::StaticOrder S; S.init(MROWS / 256, 1024 / 256, G, G == 256 ? (bx + 64) % G : bx);
          EpiKV E{Kc, Vt, ssqp, proj, rope};
          pg8::gemm_phase<EpiKV, pg8::StaticOrder, true, true>(lds, g, S, E); }
        if (s2 == 2) HOST_CONV(cvB, cvC);
        { pg8::Gemm g{proj + PC_KV, wt_kv + (size_t)1024 * KVL, KVL, NPROJP, KVL}; pg8::StaticOrder S; S.init(MROWS / 256, 1024 / 256, G, G == 256 ? (bx >= 192 ? bx - 192 : ((bx >= 68 && bx < 136) ? bx - 4 : 100000)) : G - 1 - bx);
          EpiVt E{Vt, ssqp};
          pg8::gemm_phase<EpiVt, pg8::StaticOrder, true, true, false, true>(lds, g, S, E); }
        if (s2 == 3) HOST_CONV(cvB, cvC);
        __syncthreads();
        for (int u = bx; u < T / CT; u += G) conv_unit(lds, u, proj, args.in[10], args.in[11], args.in[12], args.in[13], mix);
    }
    SEAM(2);
    if (IN(3)) {
        const bf16* Q = (const bf16*)(ws + WS_Q); const bf16* Kc = (const bf16*)(ws + WS_K); const bf16* Vt = (const bf16*)(ws + WS_V); unsigned char* mix = ws + WS_MIX;
        for (int pi = vcu; pi < NB * NH * 8; pi += G) { const int bh = pi >> 3, p = pi & 7;
            const int slot8 = (int)((((unsigned)vcu * 2654435761u) >> 13) % 8u); const int slot = slot8 < 3 ? 0 : (slot8 < 6 ? 1 : 2);
#define ATT_CONV() do { __syncthreads(); conv_items(cvA + gw, cvB, NGW, args.in[19], args.in[21], ws + WS_WT1, ws + WS_WT2, lds + wave * 16384, my_lane()); __syncthreads(); } while (0)
            if (slot == 0) ATT_CONV();
            attn_block(lds, Q, Kc, Vt, mix, bh >> 3, bh & 7, 15 - p);
            if (slot == 1) ATT_CONV();
            attn_block(lds, Q, Kc, Vt, mix, bh >> 3, bh & 7, p);
            if (slot == 2) ATT_CONV();
#undef ATT_CONV
        }
        if (vcu >= NB * NH * 8) { __syncthreads(); conv_items(cvA + gw, cvB, NGW, args.in[19], args.in[21], ws + WS_WT1, ws + WS_WT2, lds + wave * 16384, my_lane()); }
    }
    SEAM(3);
    if (IN(4)) {
        pg8::Gemm g{(const bf16*)(ws + WS_MIX), wt_out, D / 2, D / 2, D / 2}; pg8::StaticOrder S; S.init(T / 256, D / 256, G, bx);
        EpiRes E{(float*)(ws + WS_X1), args.in[0], lnstat, args.in[2], args.in[3]};
        if ((hslot & 1u) == 0u) HOST_CONV(cvC, cvD);
        pg8::gemm_phase<EpiRes, pg8::StaticOrder, true, true, true>(lds, g, S, E);
        if ((hslot & 1u) == 1u) HOST_CONV(cvC, cvD);
    }
    SEAM(4);
    int* cnt = (int*)(ctl + CW_CNT);
    int* r_e = (int*)(ws + WS_ROUTE); float* r_g = (float*)(ws + WS_ROUTE + 256 * 1024); int* r_pos = (int*)(ws + WS_ROUTE + 512 * 1024);
    bf16* h1b = (bf16*)(ws + WS_H1B); unsigned char* xg = ws + WS_XG; unsigned char* act = ws + WS_ACT; unsigned char* eo = ws + WS_EO;
    if (IN(5)) {
        const unsigned s5 = hslot % 3u; int ui5 = 0;
        if (s5 == 0) HOST_CONV(cvD, cvE);
        for (int u = bx; u < T / 16; u += G) { ln1_router_unit(lds, u, (const float*)(ws + WS_X1), args.in[15], args.in[16], args.in[17], args.in[18], h1b, xg, cnt, r_e, r_g, r_pos);
            if (++ui5 == 1 && s5 == 1) HOST_CONV(cvD, cvE); }
        if (s5 == 2 || (s5 == 1 && ui5 == 0)) HOST_CONV(cvD, cvE);
    }
    SEAM(5);
    LAS int* pre = (LAS int*)(lds + MISC_OFF + 256);
#define MOE1_STAGE(elo, ehi, cfirst, cend) do { \
        __syncthreads(); \
        moe_prefix(pre, cnt, 16, (elo), (ehi), wave * 64 + my_lane()); \
        __syncthreads(); \
        const int nun = pre[NE]; const int mine = (nun > vcu) ? (nun - vcu + G - 1) / G : 0; \
        const int kbrk = (int)((((unsigned)vcu * 2654435761u) >> 16) % (unsigned)(mine + 1)); \
        pg8::Gemm g{(const bf16*)xg, (const bf16*)(ws + WS_WT1), D / 2, D / 2, D / 2}; EpiSwiglu E{act, args.in[20]}; \
        { MoeOrder S{pre, G, vcu, 16, 0, kbrk}; pg8::gemm_phase<EpiSwiglu, MoeOrder, true, true, true>(lds, g, S, E); } \
        __syncthreads(); \
        conv_items((cfirst) + gw, (cend), NGW, args.in[19], args.in[21], ws + WS_WT1, ws + WS_WT2, lds + wave * 16384, my_lane()); \
        __syncthreads(); \
        { MoeOrder S{pre, G, vcu, 16, kbrk, mine - kbrk}; pg8::gemm_phase<EpiSwiglu, MoeOrder, true, true, true>(lds, g, S, E); } \
    } while (0)
    if (IN(6)) MOE1_STAGE(0, NE, CONV_W2, CONV_END);
    SEAM(6);
#undef MOE1_STAGE
    if (IN(7)) {
        __syncthreads();
        moe_prefix(pre, cnt, 8, 0, NE, wave * 64 + my_lane());
        __syncthreads();
        pg8::Gemm g{(const bf16*)act, (const bf16*)(ws + WS_WT2), DFF / 2, DFF / 2, DFF / 2}; MoeOrder S{pre, G, vcu, 8, 0, 1 << 30};
        EpiEo E{eo, args.in[22], lds + STG_OFF};
        pg8::gemm_phase<EpiEo, MoeOrder, true, true, true>(lds, g, S, E);
    }
    SEAM(7);
    if (IN(8)) {
        const int lane = my_lane();
        for (int r = gw; r < T; r += NGW) {
            f32x4 v[8];
#pragma unroll
            for (int j = 0; j < 8; ++j) { const v2u x = *(const v2u*)(h1b + (size_t)r * D + 4 * lane + 256 * j);
                v[j][0] = ALPHA * __uint_as_float(x.x << 16); v[j][1] = ALPHA * __uint_as_float(x.x & 0xffff0000u); v[j][2] = ALPHA * __uint_as_float(x.y << 16); v[j][3] = ALPHA * __uint_as_float(x.y & 0xffff0000u); }
#pragma unroll
            for (int k = 0; k < 4; ++k) { const float gk = r_g[r * 4 + k] * (1.0f / F8_SE); const unsigned char* src = eo + ((size_t)r_e[r * 4 + k] * CAP + r_pos[r * 4 + k]) * D;
#pragma unroll
                for (int j = 0; j < 8; ++j) { const int x = *(const int*)(src + 4 * lane + 256 * j);
                    const pg8::f32x2v lo = __builtin_amdgcn_cvt_pk_f32_fp8(x, false), hi = __builtin_amdgcn_cvt_pk_f32_fp8(x, true);
                    v[j][0] += gk * lo[0]; v[j][1] += gk * lo[1]; v[j][2] += gk * hi[0]; v[j][3] += gk * hi[1]; } }
            float s_ = 0.f;
#pragma unroll
            for (int j = 0; j < 8; ++j) s_ += (v[j][0] + v[j][1]) + (v[j][2] + v[j][3]);
            const float mean = wave_sum(s_) * (1.f / D); float s2 = 0.f;
#pragma unroll
            for (int j = 0; j < 8; ++j) { v[j] = v[j] - mean; s2 += (v[j][0] * v[j][0] + v[j][1] * v[j][1]) + (v[j][2] * v[j][2] + v[j][3] * v[j][3]); }
            const float rstd = 1.0f / sqrtf(wave_sum(s2) * (1.f / D) + LN_EPS);
#pragma unroll
            for (int j = 0; j < 8; ++j) { const int c = 4 * lane + 256 * j; const f32x4 gg = *(const f32x4*)(args.in[23] + c), bb = *(const f32x4*)(args.in[24] + c);
                *(f32x4*)(args.out + (size_t)r * D + c) = v[j] * rstd * gg + bb; }
        }
    }
#undef HOST_CONV
#undef IN
#undef SEAM
}

static int mk_grid = 0;
static void mk_launch(Args a, int lo, int hi, hipStream_t stream) {
    if (mk_grid == 0) {
        int dev = 0, cus = 0;
        (void)hipGetDevice(&dev); (void)hipDeviceGetAttribute(&cus, hipDeviceAttributeMultiprocessorCount, dev);
        if (hipFuncSetAttribute((const void*)mk_fwd, hipFuncAttributeMaxDynamicSharedMemorySize, LDS_BYTES) != hipSuccess) fprintf(stderr, "hipFuncSetAttribute failed\n");
        int per_cu = 0; (void)hipOccupancyMaxActiveBlocksPerMultiprocessor(&per_cu, (const void*)mk_fwd, NTHR, LDS_BYTES);
        if (per_cu < 1) fprintf(stderr, "occupancy query says %d\n", per_cu);
        (void)hipGetLastError();
        mk_grid = cus > 0 ? cus : 256;
    }
    a.ph_lo = lo; a.ph_hi = hi;
    hipLaunchKernelGGL(mk_fwd, dim3(mk_grid), dim3(NTHR), LDS_BYTES, stream, a);
}

extern "C" void kernel_launch(void* const* d_in, const int* in_sizes, int n_in, void* d_out, int out_size, void* d_ws, size_t ws_size, hipStream_t stream) {
    if (n_in != 25 || ws_size < WS_END) { fprintf(stderr, "kernel_launch: unexpected n_in %d or ws %zu\n", n_in, ws_size); return; }
    unsigned char* ws = (unsigned char*)d_ws;
    (void)hipMemsetAsync(ws + WS_CTL, 0, CTL_BYTES, stream);
    Args a{}; for (int i = 0; i < 25; ++i) a.in[i] = (const float*)d_in[i]; a.out = (float*)d_out; a.ws = ws;
    mk_launch(a, 0, 9, stream);
}
```

```cpp
#include <hip/hip_runtime.h>
#include <cstdio>
#include <cstdint>

typedef unsigned short bf16;
typedef __bf16 bf16x2v __attribute__((ext_vector_type(2)));
__device__ __forceinline__ float bf2f(bf16 v) { return __uint_as_float(((unsigned)v) << 16); }
__device__ __forceinline__ bf16 f2bf(float f) { unsigned u = __float_as_uint(f); return (bf16)((u + 0x7fffu + ((u >> 16) & 1u)) >> 16); }

constexpr int D = 2048, NB = 4, S = 2048, NMETA = 16, LSEQ = S + NMETA;
constexpr int T = NB * S;
constexpr int MROWS = 8448;
constexpr int NH = 8, DQK = 192, DNOPE = 128, DROPE = 64, DV = 128;
constexpr int QL = 768, KVL = 512, CC = 1024, CW = 31;
constexpr int NPROJ = 3392, NPROJP = 3584;
constexpr int PC_Q = 0, PC_KV = 768, PC_A = 1280, PC_G = 2304, PC_KPE = 3328;
constexpr int NE = 32, TOPK = 4, DFF = 2048, CAP = 8192;
constexpr int KPAD = 2112;
constexpr float ALPHA = 1.189207115002721f;
constexpr float LN_EPS = 1e-5f, RMS_EPS = 1e-6f;
constexpr float SW_LIMIT = 7.0f, SW_ALPHA = 1.702f;

constexpr size_t MiB = 1ull << 20;
constexpr size_t WS_CTL = 0, CTL_BYTES = 64 * 1024;
constexpr size_t WS_ROPE = 1 * MiB;
constexpr size_t WS_WTIN = 2 * MiB, WS_WTUQ = 18 * MiB, WS_WTKV = 21 * MiB, WS_WTOUT = 23 * MiB;
constexpr size_t WS_RSC = 48 * MiB, WS_CSC = 49 * MiB;
constexpr size_t WS_SSQP = 32 * MiB, WS_H0B = 96 * MiB, WS_PROJ = 130 * MiB, WS_Q = 188 * MiB, WS_K = 212 * MiB, WS_V = 237 * MiB;
constexpr size_t WS_MIX = 254 * MiB, WS_X1 = 286 * MiB, WS_H1B = 350 * MiB, WS_ROUTE = 414 * MiB;
constexpr size_t WS_WT1 = 416 * MiB, WS_WT2 = 672 * MiB, WS_XG = 800 * MiB, WS_ACT = 1312 * MiB, WS_EO = 1824 * MiB, WS_END = 2848 * MiB;
constexpr float F8_SX = 4.0f, F8_SW = 256.0f, F8_INV = 1.0f / (F8_SX * F8_SW), F8_SE = 64.0f;
constexpr int CW_CNT = 8192;
constexpr int CW_LNSTAT = 65536;

__device__ __forceinline__ int proj_src_col(int np) {
    if (np < 1280) return np;
    if (np < 3328) return np + 64;
    if (np < 3392) { const int i = np - 3328; return 1280 + (i >> 1) + 32 * (i & 1); }
    return -1;
}

__host__ __device__ __forceinline__ int keypos(int key) { return (key & ~31) | ((key & 0x0C) << 1) | ((key & 0x10) >> 2) | (key & 3); }

__device__ __forceinline__ float wave_sum(float v) {
#pragma unroll
    for (int o = 1; o < 64; o <<= 1) v += __shfl_xor(v, o);
    return v;
}

typedef float f32x4_t __attribute__((ext_vector_type(4)));
typedef unsigned u32x2_t __attribute__((ext_vector_type(2)));
__device__ __forceinline__ unsigned pk2_rne(float lo, float hi) { return (unsigned)f2bf(lo) | ((unsigned)f2bf(hi) << 16); }
__device__ __forceinline__ void ln_row(const float* src, const float* g, const float* b, float* stats2, bf16* dstb, int lane) {
    f32x4_t v[8]; float s = 0.f;
#pragma unroll
    for (int j = 0; j < 8; ++j) { v[j] = *(const f32x4_t*)(src + 4 * lane + 256 * j); s += (v[j][0] + v[j][1]) + (v[j][2] + v[j][3]); }
    const float mean = wave_sum(s) * (1.f / D); float s2 = 0.f;
#pragma unroll
    for (int j = 0; j < 8; ++j) { v[j] = v[j] - mean; s2 += (v[j][0] * v[j][0] + v[j][1] * v[j][1]) + (v[j][2] * v[j][2] + v[j][3] * v[j][3]); }
    const float rstd = 1.0f / sqrtf(wave_sum(s2) * (1.f / D) + LN_EPS);
    if (stats2 && lane == 0) { stats2[0] = mean; stats2[1] = rstd; }
#pragma unroll
    for (int j = 0; j < 8; ++j) { const int c = 4 * lane + 256 * j; const f32x4_t gg = *(const f32x4_t*)(g + c), bb = *(const f32x4_t*)(b + c);
        const f32x4_t o = v[j] * rstd * gg + bb; u32x2_t w; w.x = pk2_rne(o[0], o[1]); w.y = pk2_rne(o[2], o[3]); *(u32x2_t*)(dstb + c) = w; }
}

__device__ __forceinline__ float wave_max(float v) {
#pragma unroll
    for (int o = 32; o > 0; o >>= 1) v = fmaxf(v, __shfl_xor(v, o));
    return v;
}
__device__ __forceinline__ unsigned pack_i8x4(float a, float b, float c, float d) {
    const int ia = (int)a, ib = (int)b, ic = (int)c, id = (int)d;
    return (unsigned)(ia & 255) | ((unsigned)(ib & 255) << 8) | ((unsigned)(ic & 255) << 16) | ((unsigned)id << 24);
}
__device__ __forceinline__ void ln_row8(const float* src, const float* g, const float* b, float* stats2, unsigned char* dst8, float* rsc, int lane) {
    f32x4_t v[8]; float s = 0.f;
#pragma unroll
    for (int j = 0; j < 8; ++j) { v[j] = *(const f32x4_t*)(src + 4 * lane + 256 * j); s += (v[j][0] + v[j][1]) + (v[j][2] + v[j][3]); }
    const float mean = wave_sum(s) * (1.f / D); float s2 = 0.f;
#pragma unroll
    for (int j = 0; j < 8; ++j) { v[j] = v[j] - mean; s2 += (v[j][0] * v[j][0] + v[j][1] * v[j][1]) + (v[j][2] * v[j][2] + v[j][3] * v[j][3]); }
    const float rstd = 1.0f / sqrtf(wave_sum(s2) * (1.f / D) + LN_EPS);
    if (stats2 && lane == 0) { stats2[0] = mean; stats2[1] = rstd; }
    float am = 0.f;
#pragma unroll
    for (int j = 0; j < 8; ++j) { const int c = 4 * lane + 256 * j; const f32x4_t gg = *(const f32x4_t*)(g + c), bb = *(const f32x4_t*)(b + c);
        v[j] = v[j] * rstd * gg + bb; am = fmaxf(fmaxf(am, fmaxf(fabsf(v[j][0]), fabsf(v[j][1]))), fmaxf(fabsf(v[j][2]), fabsf(v[j][3]))); }
    am = wave_max(am);
    const float inv = am > 0.f ? 127.0f / am : 0.f;
    if (lane == 0) *rsc = am * (1.0f / 127.0f);
#pragma unroll
    for (int j = 0; j < 8; ++j) { const f32x4_t q = v[j] * inv; *(unsigned*)(dst8 + 4 * lane + 256 * j) = pack_i8x4(rintf(q[0]), rintf(q[1]), rintf(q[2]), rintf(q[3])); }
}

constexpr float MIX_S = 16.0f;
constexpr float QSCALE = 0.07216878364870323f * 1.4426950408889634f;

constexpr int TIDTAB_OFF = 153600 + 1024;
extern __shared__ __attribute__((aligned(16))) unsigned char lds_raw[];
__device__ __forceinline__ int hw_slot() { return (int)(__builtin_amdgcn_s_getreg((5 << 11) | 4) & 63u); }
__device__ __forceinline__ int my_lane() { int l; asm volatile("v_mbcnt_lo_u32_b32 %0, -1, 0\n\tv_mbcnt_hi_u32_b32 %0, -1, %0" : "=v"(l)); return l; }
__device__ __forceinline__ int my_tid() {
    const int wv = ((const __attribute__((address_space(3))) int*)((__attribute__((address_space(3))) unsigned char*)lds_raw + TIDTAB_OFF))[hw_slot()];
    return __builtin_amdgcn_readfirstlane(wv) * 64 + my_lane();
}
namespace pg8 {
#define PG8_LAS __attribute__((address_space(3)))
typedef unsigned short bf16_t;
typedef short bf16x8 __attribute__((ext_vector_type(8)));
typedef float f32x4 __attribute__((ext_vector_type(4)));
typedef unsigned u32x4 __attribute__((ext_vector_type(4)));
constexpr int BM = 256, BK = 64, HALF = 128, HTB = HALF * BK * 2, STAGE_BYTES = 8 * HTB, NXCD = 8, WGM = 8;

__host__ __device__ __forceinline__ int lds_byte(int r, int c) { const int st = (r >> 4) * 2 + (c >> 5), rr = r & 15, cc = c & 31, ob = rr * 64 + cc * 2; return st * 1024 + (ob ^ (((ob >> 9) & 1) << 5)); }
__host__ __device__ __forceinline__ void stage_rc(int b, int& R, int& C) { const int st = b / 1024, sb = b % 1024, swz = sb ^ (((sb >> 9) & 1) << 5); R = (st >> 1) * 16 + swz / 64; C = (st & 1) * 32 + (swz % 64) / 2; }
__host__ __device__ __forceinline__ int perm32(int rho) { const int n = rho >> 4, i = rho & 15; return 8 * (i >> 2) + 4 * n + (i & 3); }

struct Unit { int pm, pn; };
struct Gemm { const bf16_t* A; const bf16_t* Bt; int K, lda, ldb; };

struct StaticOrder {
    int nM, nN, nwg, G, c;
    __device__ void init(int nM_, int nN_, int G_, int c_) { nM = nM_; nN = nN_; nwg = nM * nN; G = G_; c = c_; }
    __device__ bool next(int i, Unit& u) const {
        const long L = (long)i * G + c; if (L >= nwg) return false;
        int wgid = (int)L; { const int q = nwg / NXCD, r = nwg % NXCD, xcd = wgid % NXCD, off = wgid / NXCD; wgid = (xcd < r ? xcd * (q + 1) : r * (q + 1) + (xcd - r) * q) + off; }
        const int nig = WGM * nN, gid = wgid / nig, fm = gid * WGM, gsz = (nM - fm) < WGM ? (nM - fm) : WGM;
        u.pm = fm + ((wgid % nig) % gsz); u.pn = (wgid % nig) / gsz; return true;
    }
};

typedef float f32x2v __attribute__((ext_vector_type(2)));
__device__ __forceinline__ unsigned cvt_pk_bf16(float lo, float hi) { const f32x2v f = {lo, hi}; const bf16x2v b = __builtin_convertvector(f, bf16x2v); return __builtin_bit_cast(unsigned, b); }

typedef int v8i_t __attribute__((ext_vector_type(8)));
typedef int v4i_t __attribute__((ext_vector_type(4)));
template <class Epi, class Sched, bool ALIGN_EPI = false, bool SP2 = false, bool F8 = false, bool SWAP = false, bool I8 = false>
__device__ __forceinline__ void gemm_phase(PG8_LAS unsigned char* lds, const Gemm g, const Sched& S, const Epi& E) {
    const int tid = my_tid(), wid = __builtin_amdgcn_readfirstlane(tid >> 6), lane = tid & 63, wr = wid >> 2, wc = wid & 3, fr = lane & 15, fq = lane >> 4;
    const int K = g.K, nt = K / BK;
    unsigned voffA[2], voffB[2];
#pragma unroll
    for (int i = 0; i < 2; ++i) { int R, C; stage_rc(tid * 16 + i * 8192, R, C); const int Rb = Epi::PERM ? ((R & ~31) + perm32(R & 31)) : R;
        voffA[i] = (unsigned)(R * g.lda + C) * 2u; voffB[i] = (unsigned)(Rb * g.ldb + C) * 2u; }
    const size_t kstep = (size_t)(BK * 2);
    const size_t hstepA = (size_t)HALF * g.lda * 2, hstepB = (size_t)HALF * g.ldb * 2;
    const size_t tstepA = 2 * hstepA, tstepB = 2 * hstepB;
    const unsigned ldsw = (unsigned)wid * 1024u;
    const int aoff = lds_byte(wr * 64 + fr, fq * 8), boff = lds_byte(wc * 32 + fr, fq * 8);
#define PG8_SA(b, h) (((b) * 2 + (h)) * HTB)
#define PG8_SB(b, h) ((4 + (b) * 2 + (h)) * HTB)
#define PG8_STAGE(bufoff, gbase, voff) do { _Pragma("unroll") for (int _i = 0; _i < 2; ++_i) \
        __builtin_amdgcn_global_load_lds((const unsigned*)((const char*)(gbase) + (voff)[_i]), (PG8_LAS unsigned*)(lds + (bufoff) + ldsw + _i * 8192), 16, 0, 0); } while (0)
#define PG8_LDA(dst, b, h) do { _Pragma("unroll") for (int m = 0; m < 4; ++m) _Pragma("unroll") for (int k = 0; k < 2; ++k) dst[m][k] = *(const PG8_LAS bf16x8*)(lds + PG8_SA(b, h) + aoff + m * 2048 + k * 1024); } while (0)
#define PG8_LDB(dst, b, h) do { _Pragma("unroll") for (int n = 0; n < 2; ++n) _Pragma("unroll") for (int k = 0; k < 2; ++k) dst[n][k] = *(const PG8_LAS bf16x8*)(lds + PG8_SB(b, h) + boff + n * 2048 + k * 1024); } while (0)
#define PG8_MMA(ai, bj, At, Bt) do { __builtin_amdgcn_s_setprio(1); \
        if constexpr (F8) { _Pragma("unroll") for (int m = 0; m < 4; ++m) _Pragma("unroll") for (int n = 0; n < 2; ++n) \
            asm volatile("v_mfma_scale_f32_16x16x128_f8f6f4 %0, %1, %2, %0, %3, %3 op_sel_hi:[0,0,0]" : "+v"(acc[ai][bj][m][n]) \
                : "v"(__builtin_shufflevector(__builtin_bit_cast(v4i_t, Bt[n][0]), __builtin_bit_cast(v4i_t, Bt[n][1]), 0, 1, 2, 3, 4, 5, 6, 7)), \
                  "v"(__builtin_shufflevector(__builtin_bit_cast(v4i_t, At[m][0]), __builtin_bit_cast(v4i_t, At[m][1]), 0, 1, 2, 3, 4, 5, 6, 7)), "v"(f8scale)); } \
        else if constexpr (I8) { _Pragma("unroll") for (int m = 0; m < 4; ++m) _Pragma("unroll") for (int n = 0; n < 2; ++n) _Pragma("unroll") for (int k = 0; k < 2; ++k) \
            acc[ai][bj][m][n] = __builtin_bit_cast(f32x4, __builtin_amdgcn_mfma_i32_16x16x64_i8(__builtin_bit_cast(v4i_t, Bt[n][k]), __builtin_bit_cast(v4i_t, At[m][k]), __builtin_bit_cast(v4i_t, acc[ai][bj][m][n]), 0, 0, 0)); } \
        else { _Pragma("unroll") for (int m = 0; m < 4; ++m) _Pragma("unroll") for (int n = 0; n < 2; ++n) _Pragma("unroll") for (int k = 0; k < 2; ++k) \
            acc[ai][bj][m][n] = SWAP ? __builtin_amdgcn_mfma_f32_16x16x32_bf16(At[m][k], Bt[n][k], acc[ai][bj][m][n], 0, 0, 0) \
                                     : __builtin_amdgcn_mfma_f32_16x16x32_bf16(Bt[n][k], At[m][k], acc[ai][bj][m][n], 0, 0, 0); } \
        __builtin_amdgcn_s_setprio(0); } while (0)
#define PG8_WAIT_V(n) asm volatile("s_waitcnt vmcnt(" #n ")" ::: "memory")
#define PG8_WAIT_L(n) asm volatile("s_waitcnt lgkmcnt(" #n ")" ::: "memory")
#define PG8_BAR __builtin_amdgcn_s_barrier()
#define PG8_SCHED __builtin_amdgcn_sched_barrier(0)
    Unit cur, nxt; int ui = 0;
    if (!S.next(0, cur)) return;
    int f8scale = 0x7F7F7F7F; asm volatile("" : "+v"(f8scale));
    f32x4 acc[2][2][4][2];
#pragma unroll
    for (int a = 0; a < 2; ++a)
#pragma unroll
        for (int b = 0; b < 2; ++b)
#pragma unroll
            for (int m = 0; m < 4; ++m)
#pragma unroll
                for (int n = 0; n < 2; ++n) acc[a][b][m][n] = (f32x4){0.f, 0.f, 0.f, 0.f};
    bf16x8 At[4][2], B0[2][2], B1[2][2];
    const char* cA = (const char*)g.A + (size_t)cur.pm * tstepA; const char* cB = (const char*)g.Bt + (size_t)cur.pn * tstepB;
    if constexpr (SP2) {
        PG8_STAGE(PG8_SB(0, 0), cB, voffB); PG8_STAGE(PG8_SB(0, 1), cB + hstepB, voffB); PG8_STAGE(PG8_SA(0, 0), cA, voffA); PG8_STAGE(PG8_SA(0, 1), cA + hstepA, voffA);
        if (wr == 1) PG8_BAR;
        PG8_WAIT_V(2); PG8_BAR;
        PG8_STAGE(PG8_SB(1, 0), cB + kstep, voffB); PG8_STAGE(PG8_SA(1, 0), cA + kstep, voffA); PG8_STAGE(PG8_SB(1, 1), cB + hstepB + kstep, voffB);
        PG8_WAIT_V(6); PG8_BAR;
    } else {
        PG8_STAGE(PG8_SB(0, 0), cB, voffB); PG8_STAGE(PG8_SA(0, 0), cA, voffA); PG8_STAGE(PG8_SB(0, 1), cB + hstepB, voffB); PG8_STAGE(PG8_SA(0, 1), cA + hstepA, voffA);
        if (wr == 1) PG8_BAR;
        PG8_WAIT_V(4); PG8_BAR;
        PG8_STAGE(PG8_SB(1, 0), cB + kstep, voffB); PG8_STAGE(PG8_SA(1, 0), cA + kstep, voffA); PG8_STAGE(PG8_SB(1, 1), cB + hstepB + kstep, voffB);
        PG8_WAIT_V(6); PG8_BAR;
    }
    for (;;) {
        const bool has_next = S.next(ui + 1, nxt);
        if constexpr (Epi::STAGED) E.pre(cur, ui, wid, lane);
        const char* nA = has_next ? (const char*)g.A + (size_t)nxt.pm * tstepA : cA; const char* nB = has_next ? (const char*)g.Bt + (size_t)nxt.pn * tstepB : cB;
        for (int t = 0; t < nt; t += 2) {
            const bool last = (t == nt - 2);
            const char* a1 = cA + (size_t)(t + 1) * kstep;
            const char* a2 = last ? nA : cA + (size_t)(t + 2) * kstep; const char* b2 = last ? nB : cB + (size_t)(t + 2) * kstep;
            const char* a3 = a2 + kstep; const char* b3 = b2 + kstep;
            if constexpr (SP2) {
            PG8_LDB(B0, 0, 0); PG8_LDB(B1, 0, 1); PG8_SCHED; PG8_LDA(At, 0, 0); PG8_STAGE(PG8_SA(1, 1), a1 + hstepA, voffA);
            PG8_WAIT_V(8); PG8_WAIT_L(0); PG8_BAR; PG8_MMA(0, 0, At, B0); PG8_MMA(0, 1, At, B1); PG8_BAR; PG8_SCHED;
            PG8_LDA(At, 0, 1); PG8_STAGE(PG8_SB(0, 0), b2, voffB); PG8_STAGE(PG8_SB(0, 1), b2 + hstepB, voffB); PG8_STAGE(PG8_SA(0, 0), a2, voffA);
            PG8_WAIT_V(8); PG8_WAIT_L(0); PG8_BAR; PG8_MMA(1, 0, At, B0); PG8_MMA(1, 1, At, B1); PG8_BAR; PG8_SCHED;
            PG8_LDB(B0, 1, 0); PG8_LDB(B1, 1, 1); PG8_SCHED; PG8_LDA(At, 1, 0); PG8_STAGE(PG8_SA(0, 1), a2 + hstepA, voffA);
            PG8_WAIT_V(8); PG8_WAIT_L(0); PG8_BAR; PG8_MMA(0, 0, At, B0); PG8_MMA(0, 1, At, B1); PG8_BAR; PG8_SCHED;
            PG8_LDA(At, 1, 1); PG8_STAGE(PG8_SB(1, 0), b3, voffB); PG8_STAGE(PG8_SB(1, 1), b3 + hstepB, voffB); PG8_STAGE(PG8_SA(1, 0), a3, voffA);
            PG8_WAIT_V(8); PG8_WAIT_L(0); PG8_BAR; PG8_MMA(1, 0, At, B0); PG8_MMA(1, 1, At, B1); PG8_BAR; PG8_SCHED;
            } else {
            PG8_LDB(B0, 0, 0); PG8_SCHED; PG8_LDA(At, 0, 0); PG8_STAGE(PG8_SA(1, 1), a1 + hstepA, voffA);
            PG8_WAIT_L(8); PG8_BAR; PG8_WAIT_L(0); PG8_MMA(0, 0, At, B0); PG8_BAR; PG8_SCHED;
            PG8_LDB(B1, 0, 1); PG8_STAGE(PG8_SB(0, 0), b2, voffB);
            PG8_BAR; PG8_WAIT_L(0); PG8_MMA(0, 1, At, B1); PG8_BAR;
            PG8_LDA(At, 0, 1); PG8_STAGE(PG8_SA(0, 0), a2, voffA);
            PG8_BAR; PG8_WAIT_L(0); PG8_MMA(1, 0, At, B0); PG8_BAR; PG8_SCHED;
            PG8_STAGE(PG8_SB(0, 1), b2 + hstepB, voffB);
            PG8_WAIT_V(6); PG8_BAR; PG8_MMA(1, 1, At, B1); PG8_BAR;
            PG8_LDB(B0, 1, 0); PG8_SCHED; PG8_LDA(At, 1, 0); PG8_STAGE(PG8_SA(0, 1), a2 + hstepA, voffA);
            PG8_WAIT_L(8); PG8_BAR; PG8_WAIT_L(0); PG8_MMA(0, 0, At, B0); PG8_BAR; PG8_SCHED;
            PG8_LDB(B1, 1, 1); PG8_STAGE(PG8_SB(1, 0), b3, voffB);
            PG8_BAR; PG8_WAIT_L(0); PG8_MMA(0, 1, At, B1); PG8_BAR;
            PG8_LDA(At, 1, 1); PG8_STAGE(PG8_SA(1, 0), a3, voffA);
            PG8_BAR; PG8_WAIT_L(0); PG8_MMA(1, 0, At, B0); PG8_BAR; PG8_SCHED;
            PG8_STAGE(PG8_SB(1, 1), b3 + hstepB, voffB);
            PG8_WAIT_V(6); PG8_BAR; PG8_MMA(1, 1, At, B1); PG8_BAR;
            }
        }
        if constexpr (F8) asm volatile("s_nop 15\n\ts_nop 15" ::: "memory");
        if constexpr (ALIGN_EPI) { if (wr == 0) PG8_BAR; }
        { int tz = my_tid(); asm volatile("" : "+v"(tz));
          const int lz = tz & 63; if constexpr (Epi::STAGED) E.run(acc, cur, wr, wc, lz & 15, lz >> 4, tz, ui); else E(acc, cur, wr, wc, lz & 15, lz >> 4); }
        if (!has_next) break;
#pragma unroll
        for (int a = 0; a < 2; ++a)
#pragma unroll
            for (int b = 0; b < 2; ++b)
#pragma unroll
                for (int m = 0; m < 4; ++m)
#pragma unroll
                    for (int n = 0; n < 2; ++n) acc[a][b][m][n] = (f32x4){0.f, 0.f, 0.f, 0.f};
        cur = nxt; cA = nA; cB = nB; ++ui;
        if constexpr (ALIGN_EPI) { if (wr == 1) PG8_BAR; }
    }
    PG8_WAIT_V(0);
    if constexpr (!ALIGN_EPI) { if (wr == 0) PG8_BAR; }
    PG8_BAR;
#undef PG8_SA
#undef PG8_SB
#undef PG8_STAGE
#undef PG8_LDA
#undef PG8_LDB
#undef PG8_MMA
#undef PG8_WAIT_V
#undef PG8_WAIT_L
#undef PG8_BAR
#undef PG8_SCHED
}
}

#define GAS __attribute__((address_space(1)))
#define LAS __attribute__((address_space(3)))
typedef unsigned v4u __attribute__((ext_vector_type(4)));
typedef unsigned v2u __attribute__((ext_vector_type(2)));
typedef float f32x4 __attribute__((ext_vector_type(4)));
typedef short bf16x8 __attribute__((ext_vector_type(8)));
#define LDS_WAIT() asm volatile("s_waitcnt lgkmcnt(0)" ::: "memory")
#define VM_WAIT() asm volatile("s_waitcnt vmcnt(0)" ::: "memory")
__device__ __forceinline__ unsigned pk2(float lo, float hi) { return pg8::cvt_pk_bf16(lo, hi); }

constexpr int NWAVES = 8, NTHR = 512;
constexpr int CONV_P3_PER_WAVE = 20, CONV_P2_PER_WAVE = 5, CONV_P4_PER_WAVE = 3, CONV_P5_PER_WAVE = 2;
constexpr int CONV_W1B = 16 * 2048, CONV_W2 = 32 * 2048, CONV_END = 32 * 2048 + 32 * 1024;
constexpr int CONV_P1 = 50 * 8 * 7;
constexpr int RING_BYTES = 131072, MISC_OFF = 153600, LDS_BYTES = 155648;
constexpr int CW_BAR = 4096;

#define XB_TMO      128
#define XB_XCNT(j)  (256  + 64 * (j))
#define XB_XSUB(j)  (1280 + 64 * (j))
#define XB_XGEN(j)  (2304 + 64 * (j))
#define XB_TOP      3328
#define XB_TOPGEN   3392
#define XCD_BAR_WORDS 3456
#define XB_SPIN_CAP (1u << 18)
__device__ __forceinline__ unsigned xb_ld(unsigned* p)              { return __hip_atomic_load(p, __ATOMIC_RELAXED, __HIP_MEMORY_SCOPE_AGENT); }
__device__ __forceinline__ unsigned xb_add(unsigned* p, unsigned v) { return __hip_atomic_fetch_add(p, v, __ATOMIC_RELAXED, __HIP_MEMORY_SCOPE_AGENT); }
__device__ __forceinline__ unsigned xb_xcc_id() { return (unsigned)__builtin_amdgcn_s_getreg((3 << 11) | 20) & 0xFu; }
#define XB_SPIN(cond, bar) do { unsigned _sp = 0; while (cond) { __builtin_amdgcn_s_sleep(1); \
    if ((++_sp & 255u) == 0u) { if (xb_ld(&(bar)[XB_TMO])) break; if (_sp > XB_SPIN_CAP) { atomicAdd(&(bar)[XB_TMO], 1u); break; } } } } while (0)
struct XcdBarrier { unsigned* bar; unsigned x; volatile LAS unsigned* st; };
__device__ __forceinline__ XcdBarrier xcd_barrier_post(unsigned* bar, volatile LAS unsigned* st) {
    XcdBarrier b; b.bar = bar; b.x = xb_xcc_id(); b.st = st;
    if (my_tid() == 0) (void)xb_add(&bar[XB_XCNT(b.x)], 1u);
    return b;
}
__device__ __forceinline__ void xcd_barrier_complete(unsigned* bar, unsigned x, unsigned& nloc, unsigned& nx) {
    const unsigned G = gridDim.x * gridDim.y * gridDim.z;
    unsigned sum, cnt, mine, sp = 0u;
    for (;;) {
        sum = 0u; cnt = 0u; mine = 0u;
#pragma unroll
        for (unsigned j = 0; j < 16; ++j) { const unsigned c = xb_ld(&bar[XB_XCNT(j)]); sum += c; cnt += (c > 0u) ? 1u : 0u; mine = (j == x) ? c : mine; }
        if (sum == G) break;
        __builtin_amdgcn_s_sleep(1);
        if ((++sp & 255u) == 0u) { if (xb_ld(&bar[XB_TMO])) break; if (sp > XB_SPIN_CAP) { atomicAdd(&bar[XB_TMO], 1u); break; } }
    }
    nloc = mine > 0u ? mine : 1u; nx = cnt > 0u ? cnt : 1u;
}
__device__ __forceinline__ void xcd_barrier(const XcdBarrier& b) {
    asm volatile("s_waitcnt vmcnt(0)" ::: "memory");
    __syncthreads();
    if (my_tid() == 0) {
        unsigned* bar = b.bar;
        __builtin_amdgcn_s_waitcnt(0);
        unsigned nloc = b.st[0], nx = b.st[1];
        if (nloc == 0u) { xcd_barrier_complete(bar, b.x, nloc, nx); b.st[0] = nloc; b.st[1] = nx; }
        const unsigned old = xb_add(&bar[XB_XSUB(b.x)], 1u);
        const unsigned gen = old / nloc;
        if (old + 1u == (gen + 1u) * nloc) {
            __builtin_amdgcn_fence(__ATOMIC_RELEASE, "agent");
            asm volatile("s_waitcnt vmcnt(0)" ::: "memory");
            const unsigned og = xb_add(&bar[XB_TOP], 1u);
            const unsigned tg = og / nx;
            if (og + 1u == (tg + 1u) * nx) xb_add(&bar[XB_TOPGEN], 1u);
            else XB_SPIN(xb_ld(&bar[XB_TOPGEN]) == tg, bar);
            __builtin_amdgcn_fence(__ATOMIC_ACQUIRE, "agent");
            xb_add(&bar[XB_XGEN(b.x)], 1u);
            asm volatile("s_waitcnt vmcnt(0)" ::: "memory");
        } else {
            XB_SPIN(xb_ld(&bar[XB_XGEN(b.x)]) == gen, bar);
            __builtin_amdgcn_fence(__ATOMIC_ACQUIRE, "agent");
            asm volatile("s_waitcnt vmcnt(0)" ::: "memory");
        }
    }
    __syncthreads();
}

struct Args { const float* in[25]; float* out; unsigned char* ws; int ph_lo, ph_hi; };

template <class SrcCol>
__device__ __forceinline__ void transpose_item(const float* W, int ldw, int K, bf16* WT, int n0, int k0, const SrcCol& sc, const float* kscale, LAS float* scr, int lane) {
    const int csrc = sc(n0 + (lane & 31));
#pragma unroll 8
    for (int i = 0; i < 32; ++i) { const int kk = 2 * i + (lane >> 5);
        float v = 0.f; if (csrc >= 0) { v = W[(size_t)(k0 + kk) * ldw + csrc]; if (kscale) v *= kscale[k0 + kk]; }
        scr[kk * 33 + (lane & 31)] = v; }
    LDS_WAIT(); asm volatile("" ::: "memory");
    const int c = lane & 7;
#pragma unroll
    for (int j = 0; j < 4; ++j) { const int n = (lane >> 3) + 8 * j; const LAS float* s = scr + (8 * c) * 33 + n;
        v4u o; o.x = pk2(s[0 * 33], s[1 * 33]); o.y = pk2(s[2 * 33], s[3 * 33]); o.z = pk2(s[4 * 33], s[5 * 33]); o.w = pk2(s[6 * 33], s[7 * 33]);
        *(v4u*)(WT + (size_t)(n0 + n) * K + k0 + 8 * c) = o; }
    LDS_WAIT(); asm volatile("" ::: "memory");
}

typedef short v4i16_t __attribute__((ext_vector_type(4)));
__device__ __forceinline__ int tsw(int kk) { return ((kk >> 1) & 1) | (((kk >> 4) & 1) << 1); }
typedef short s16x2_t __attribute__((ext_vector_type(2)));
__device__ __forceinline__ unsigned f8x4(unsigned lo2, unsigned hi2) {
    s16x2_t r = {0, 0};
    r = __builtin_amdgcn_cvt_scalef32_pk_fp8_bf16(r, __builtin_bit_cast(bf16x2v, lo2), 1.0f / F8_SW, false);
    r = __builtin_amdgcn_cvt_scalef32_pk_fp8_bf16(r, __builtin_bit_cast(bf16x2v, hi2), 1.0f / F8_SW, true);
    return __builtin_bit_cast(unsigned, r);
}
struct TI64 { const float* src; unsigned char* dst; int ldw, K; };
__device__ __forceinline__ TI64 ti64_desc(int it, const float* w1, const float* w2, unsigned char* wt1, unsigned char* wt2, int lane) {
    constexpr int I1 = (D / 128) * (4096 / 32), I2 = (DFF / 128) * (D / 32);
    const int r8 = lane >> 3, c8 = lane & 7; TI64 t;
    if (it < NE * I1) { const int e = it / I1, r = it - e * I1, nb = r & 127, kb = r >> 7; const int pn = nb >> 3, j0 = (nb & 7) * 32;
        const int src0 = (j0 < 128) ? (128 * pn + j0) : (2048 + 128 * pn + j0 - 128);
        t.ldw = 4096; t.K = D; t.src = w1 + (size_t)e * D * 4096 + (size_t)(128 * kb + r8) * 4096 + src0 + 4 * c8; t.dst = wt1 + (size_t)e * 4096 * D + (size_t)(32 * nb) * D + 128 * kb; }
    else { const int q = it - NE * I1, e = q / I2, r = q - e * I2, nb = r & 63, kb = r >> 6;
        t.ldw = D; t.K = DFF; t.src = w2 + (size_t)e * DFF * D + (size_t)(128 * kb + r8) * D + 32 * nb + 4 * c8; t.dst = wt2 + (size_t)e * D * DFF + (size_t)(32 * nb) * DFF + 128 * kb; }
    return t;
}
__device__ __forceinline__ void ti64_load(const TI64& t, f32x4 (&v)[16]) {
#pragma unroll
    for (int i = 0; i < 16; ++i) v[i] = __builtin_nontemporal_load((const f32x4*)(t.src + (size_t)(8 * i) * t.ldw));
}
__device__ __forceinline__ void ti64_store(const TI64& t, const f32x4 (&v)[16], LAS unsigned char* tile, int lane) {
    const int r8 = lane >> 3, c8 = lane & 7;
#pragma unroll
    for (int i = 0; i < 16; ++i) { const int kk = 8 * i + r8;
        v2u o; o.x = pg8::cvt_pk_bf16(v[i][0], v[i][1]); o.y = pg8::cvt_pk_bf16(v[i][2], v[i][3]);
        *(LAS v2u*)(tile + kk * 64 + ((((c8 >> 2) ^ (kk >> 4)) & 1) << 5) + ((c8 & 3) << 3)) = o; }
    asm volatile("" ::: "memory");
    const int G = lane >> 4, i16 = lane & 15, q = i16 >> 2, p = i16 & 3; const bool hi = i16 >= 8;
#pragma unroll
    for (int nbu = 0; nbu < 2; ++nbu) { unsigned oe[4], oo[4];
#pragma unroll
        for (int h = 0; h < 2; ++h) { const int c = 4 * h + G;
#pragma unroll
            for (int j = 0; j < 4; ++j) { const int kk = 16 * c + 4 * j + q;
                const v4i16_t tr = __builtin_amdgcn_ds_read_tr16_b64_v4i16((LAS v4i16_t*)(tile + kk * 64 + (((nbu ^ c) & 1) << 5) + (p << 3)));
                const v2u tu = __builtin_bit_cast(v2u, tr); (h ? oo : oe)[j] = f8x4(tu.x, tu.y); } }
        v4u sa, sb;
#pragma unroll
        for (int j = 0; j < 4; ++j) { const unsigned send = hi ? oe[j] : oo[j]; const unsigned recv = (unsigned)__builtin_amdgcn_mov_dpp((int)send, 0x128, 0xf, 0xf, true);
            const unsigned a_ = hi ? recv : oe[j], b_ = hi ? oo[j] : recv; sa[j] = a_; sb[j] = b_; }
        unsigned char* rowp = t.dst + (size_t)(16 * nbu + (i16 & 7)) * t.K + 16 * (G + (hi ? 4 : 0));
        __builtin_nontemporal_store(sa, (v4u*)rowp);
        __builtin_nontemporal_store(sb, (v4u*)(rowp + (size_t)8 * t.K)); }
    asm volatile("" ::: "memory");
}

__device__ __forceinline__ void tb16_item(const float* W, int ldw, int K, bf16* WT, int n0, int src0, int k0, const float* kscale, LAS unsigned char* tile, int lane) {
    const int r8 = lane >> 3, c8 = lane & 7;
    f32x4 v[16];
    const float* src = W + (size_t)(k0 + r8) * ldw + src0 + 4 * c8;
#pragma unroll
    for (int i = 0; i < 16; ++i) v[i] = __builtin_nontemporal_load((const f32x4*)(src + (size_t)(8 * i) * ldw));
#pragma unroll
    for (int i = 0; i < 16; ++i) { const int kk = 8 * i + r8; const float sc = kscale ? kscale[k0 + kk] : 1.0f;
        v2u o; o.x = pg8::cvt_pk_bf16(v[i][0] * sc, v[i][1] * sc); o.y = pg8::cvt_pk_bf16(v[i][2] * sc, v[i][3] * sc);
        *(LAS v2u*)(tile + kk * 64 + ((((c8 >> 2) ^ (kk >> 4)) & 1) << 5) + ((c8 & 3) << 3)) = o; }
    asm volatile("" ::: "memory");
    const int G = lane >> 4, i16 = lane & 15, q = i16 >> 2, p = i16 & 3;
#pragma unroll
    for (int tt = 0; tt < 4; ++tt) { const int nbu = tt >> 1, c = 4 * (tt & 1) + G; v4u o0, o1; unsigned ov[8];
#pragma unroll
        for (int j = 0; j < 4; ++j) { const int kk = 16 * c + 4 * j + q;
            const v4i16_t tr = __builtin_amdgcn_ds_read_tr16_b64_v4i16((LAS v4i16_t*)(tile + kk * 64 + (((nbu ^ c) & 1) << 5) + (p << 3)));
            const v2u tu = __builtin_bit_cast(v2u, tr); ov[2 * j] = tu.x; ov[2 * j + 1] = tu.y; }
        o0.x = ov[0]; o0.y = ov[1]; o0.z = ov[2]; o0.w = ov[3]; o1.x = ov[4]; o1.y = ov[5]; o1.z = ov[6]; o1.w = ov[7];
        bf16* dst = WT + (size_t)(n0 + 16 * nbu + i16) * K + k0 + 16 * c;
        *(v4u*)dst = o0; *(v4u*)(dst + 8) = o1; }
    asm volatile("" ::: "memory");
}
__device__ __forceinline__ void conv_items(int first, int end, int stride, const float* w1, const float* w2, unsigned char* wt1, unsigned char* wt2, LAS unsigned char* tile, int lane) {
    if (first >= end) return;
    const int n = (end - first + stride - 1) / stride;
    f32x4 va[16], vb[16]; TI64 ta, tb;
    ta = ti64_desc(first, w1, w2, wt1, wt2, lane); ti64_load(ta, va);
    int k = 1;
    while (k + 1 < n) {
        tb = ti64_desc(first + k * stride, w1, w2, wt1, wt2, lane); ti64_load(tb, vb);
        ti64_store(ta, va, tile, lane);
        ta = ti64_desc(first + (k + 1) * stride, w1, w2, wt1, wt2, lane); ti64_load(ta, va);
        ti64_store(tb, vb, tile, lane);
        k += 2;
    }
    if (k < n) { tb = ti64_desc(first + k * stride, w1, w2, wt1, wt2, lane); ti64_load(tb, vb); ti64_store(ta, va, tile, lane); ti64_store(tb, vb, tile, lane); }
    else ti64_store(ta, va, tile, lane);
}
__device__ __forceinline__ unsigned i8x4(unsigned lo2, unsigned hi2) {
    return pack_i8x4(__uint_as_float(lo2 << 16), __uint_as_float(lo2 & 0xffff0000u), __uint_as_float(hi2 << 16), __uint_as_float(hi2 & 0xffff0000u));
}
__device__ __forceinline__ void ti64_store_i8(const TI64& t, const f32x4 (&v)[16], LAS unsigned char* tile, int lane) {
    const int r8 = lane >> 3, c8 = lane & 7;
#pragma unroll
    for (int i = 0; i < 16; ++i) { const int kk = 8 * i + r8;
        v2u o; o.x = pg8::cvt_pk_bf16(v[i][0], v[i][1]); o.y = pg8::cvt_pk_bf16(v[i][2], v[i][3]);
        *(LAS v2u*)(tile + kk * 64 + ((((c8 >> 2) ^ (kk >> 4)) & 1) << 5) + ((c8 & 3) << 3)) = o; }
    asm volatile("" ::: "memory");
    const int G = lane >> 4, i16 = lane & 15, q = i16 >> 2, p = i16 & 3;
#pragma unroll
    for (int tt = 0; tt < 4; ++tt) { const int nbu = tt >> 1, c = 4 * (tt & 1) + G; v4u o; unsigned ov[4];
#pragma unroll
        for (int j = 0; j < 4; ++j) { const int kk = 16 * c + 4 * j + q;
            const v4i16_t tr = __builtin_amdgcn_ds_read_tr16_b64_v4i16((LAS v4i16_t*)(tile + kk * 64 + (((nbu ^ c) & 1) << 5) + (p << 3)));
            const v2u tu = __builtin_bit_cast(v2u, tr); ov[j] = i8x4(tu.x, tu.y); }
        o.x = ov[0]; o.y = ov[1]; o.z = ov[2]; o.w = ov[3];
        *(v4u*)(t.dst + (size_t)(16 * nbu + i16) * t.K + 16 * c) = o; }
    asm volatile("" ::: "memory");
}
__device__ __forceinline__ void wtin_block(LAS unsigned char* lds, int nb, const float* W, unsigned char* wt8, float* csc, int tid) {
    const int lane = tid & 63, wave = tid >> 6, r8 = lane >> 3, c8 = lane & 7;
    int sc[4];
#pragma unroll
    for (int q = 0; q < 4; ++q) sc[q] = proj_src_col(32 * nb + 4 * c8 + q);
    const bool contig = nb < 104;
    f32x4 v[2][16];
#pragma unroll
    for (int it = 0; it < 2; ++it)
#pragma unroll
        for (int i = 0; i < 16; ++i) { const float* rowp = W + (size_t)(128 * (2 * wave + it) + 8 * i + r8) * NPROJ;
            if (contig) v[it][i] = __builtin_nontemporal_load((const f32x4*)(rowp + sc[0]));
            else {
#pragma unroll
                for (int q = 0; q < 4; ++q) v[it][i][q] = sc[q] >= 0 ? rowp[sc[q]] : 0.f; } }
    float am[4] = {0.f, 0.f, 0.f, 0.f};
#pragma unroll
    for (int it = 0; it < 2; ++it)
#pragma unroll
        for (int i = 0; i < 16; ++i)
#pragma unroll
            for (int q = 0; q < 4; ++q) am[q] = fmaxf(am[q], fabsf(v[it][i][q]));
    LAS float* cm = (LAS float*)(lds + 131072);
#pragma unroll
    for (int q = 0; q < 4; ++q) { am[q] = fmaxf(am[q], __shfl_xor(am[q], 8)); am[q] = fmaxf(am[q], __shfl_xor(am[q], 16)); am[q] = fmaxf(am[q], __shfl_xor(am[q], 32)); }
    if (r8 == 0) {
#pragma unroll
        for (int q = 0; q < 4; ++q) cm[wave * 32 + 4 * c8 + q] = am[q]; }
    __syncthreads();
    float inv[4];
#pragma unroll
    for (int q = 0; q < 4; ++q) { float m = 0.f;
#pragma unroll
        for (int w = 0; w < 8; ++w) m = fmaxf(m, cm[w * 32 + 4 * c8 + q]);
        inv[q] = m > 0.f ? 127.0f / m : 0.f; if (wave == 0 && r8 == 0) csc[32 * nb + 4 * c8 + q] = m * (1.0f / 127.0f); }
#pragma unroll
    for (int it = 0; it < 2; ++it) {
#pragma unroll
        for (int i = 0; i < 16; ++i)
#pragma unroll
            for (int q = 0; q < 4; ++q) v[it][i][q] = rintf(v[it][i][q] * inv[q]);
        TI64 t; t.src = nullptr; t.ldw = 0; t.K = D; t.dst = wt8 + (size_t)(32 * nb) * D + 128 * (2 * wave + it);
        ti64_store_i8(t, v[it], lds + wave * 16384, lane); }
    __syncthreads();
}
struct SC_in  { __device__ int operator()(int n) const { return proj_src_col(n); } };
struct SC_uq  { __device__ int operator()(int n) const { const int h = n / DQK, d = n - h * DQK; if (d < 128) return n; const int i = d - 128; return h * DQK + 128 + (i >> 1) + 32 * (i & 1); } };
struct SC_id  { __device__ int operator()(int n) const { return n; } };
struct SC_w1  { __device__ int operator()(int n) const { const int pn = n >> 8, j = n & 255; return (j < 128) ? (128 * pn + j) : (2048 + 128 * pn + j - 128); } };

struct EpiProj { static constexpr bool PERM = true, STAGED = false;
    bf16* proj; float* ssqp; const float* rsc; const float* csc;
    __device__ __forceinline__ void operator()(const f32x4 (&acc)[2][2][4][2], const pg8::Unit& u, int wr, int wc, int fr, int fq) const {
        const int row0 = u.pm * 256 + wr * 64 + fr, col0 = u.pn * 256 + wc * 32 + 8 * fq;
#pragma unroll
        for (int ai = 0; ai < 2; ++ai)
#pragma unroll
            for (int m = 0; m < 4; ++m) { const int r = row0 + ai * 128 + m * 16; float ss = 0.f; const float rs = rsc[r];
#pragma unroll
                for (int bj = 0; bj < 2; ++bj) { const f32x4 c0 = *(const f32x4*)(csc + col0 + bj * 128), c1 = *(const f32x4*)(csc + col0 + bj * 128 + 4);
                    const f32x4 v0 = __builtin_convertvector(__builtin_bit_cast(pg8::v4i_t, acc[ai][bj][m][0]), f32x4) * c0 * rs, v1 = __builtin_convertvector(__builtin_bit_cast(pg8::v4i_t, acc[ai][bj][m][1]), f32x4) * c1 * rs;
                    v4u o; o.x = pk2(v0[0], v0[1]); o.y = pk2(v0[2], v0[3]); o.z = pk2(v1[0], v1[1]); o.w = pk2(v1[2], v1[3]);
                    *(v4u*)(proj + (size_t)r * NPROJP + col0 + bj * 128) = o;
                    ss += v0[0] * v0[0] + v0[1] * v0[1] + v0[2] * v0[2] + v0[3] * v0[3] + v1[0] * v1[0] + v1[1] * v1[1] + v1[2] * v1[2] + v1[3] * v1[3]; }
                if (u.pn < 5) { ss += __shfl_xor(ss, 16); ss += __shfl_xor(ss, 32); if (fq == 0) ssqp[(size_t)r * 20 + 4 * u.pn + wc] = ss; } }
    }
};


__device__ __forceinline__ float ssq_q_of(const float* ssqp, int r) { const f32x4* p = (const f32x4*)(ssqp + (size_t)r * 20); const f32x4 a = p[0], b = p[1], c = p[2];
    return ((a[0] + a[1]) + (a[2] + a[3])) + ((b[0] + b[1]) + (b[2] + b[3])) + ((c[0] + c[1]) + (c[2] + c[3])); }
__device__ __forceinline__ float ssq_kv_of(const float* ssqp, int r) { const f32x4* p = (const f32x4*)(ssqp + (size_t)r * 20 + 12); const f32x4 a = p[0], b = p[1];
    return ((a[0] + a[1]) + (a[2] + a[3])) + ((b[0] + b[1]) + (b[2] + b[3])); }
struct EpiQ { static constexpr bool PERM = true, STAGED = false;
    bf16* Q; const float* ssqp; const float* rope;
    __device__ __forceinline__ void operator()(const f32x4 (&acc)[2][2][4][2], const pg8::Unit& u, int wr, int wc, int fr, int fq) const {
        const int row0 = u.pm * 256 + wr * 64 + fr;
#pragma unroll
        for (int ai = 0; ai < 2; ++ai)
#pragma unroll
            for (int m = 0; m < 4; ++m) { const int r = row0 + ai * 128 + m * 16; const int b = r >> 11, s = r & 2047, pos = s + NMETA;
                const float rs = (1.0f / sqrtf(ssq_q_of(ssqp, r) * (1.f / QL) + RMS_EPS)) * QSCALE;
#pragma unroll
                for (int bj = 0; bj < 2; ++bj) { const int c0 = u.pn * 256 + bj * 128 + wc * 32 + 8 * fq; const int h = c0 / DQK, d0 = c0 - h * DQK;
                    f32x4 v0 = acc[ai][bj][m][0] * rs, v1 = acc[ai][bj][m][1] * rs;
                    if (d0 >= 128) { const f32x4* rp = (const f32x4*)(rope + (size_t)(pos * 32 + ((d0 - 128) >> 1)) * 2); const f32x4 r0 = rp[0], r1 = rp[1];
                        f32x4 w0, w1;
                        w0[0] = v0[0] * r0[0] - v0[1] * r0[1]; w0[1] = v0[1] * r0[0] + v0[0] * r0[1];
                        w0[2] = v0[2] * r0[2] - v0[3] * r0[3]; w0[3] = v0[3] * r0[2] + v0[2] * r0[3];
                        w1[0] = v1[0] * r1[0] - v1[1] * r1[1]; w1[1] = v1[1] * r1[0] + v1[0] * r1[1];
                        w1[2] = v1[2] * r1[2] - v1[3] * r1[3]; w1[3] = v1[3] * r1[2] + v1[2] * r1[3];
                        v0 = w0; v1 = w1; }
                    v4u o; o.x = pk2(v0[0], v0[1]); o.y = pk2(v0[2], v0[3]); o.z = pk2(v1[0], v1[1]); o.w = pk2(v1[2], v1[3]);
                    *(v4u*)(Q + (((size_t)b * NH + h) * S + s) * DQK + d0) = o; } }
    }
};
struct EpiKV { static constexpr bool PERM = true, STAGED = false;
    bf16* Kc; bf16* Vt; const float* ssqp; const bf16* proj; const float* rope;
    __device__ __forceinline__ void operator()(const f32x4 (&acc)[2][2][4][2], const pg8::Unit& u, int wr, int wc, int fr, int fq) const {
        const int row0 = u.pm * 256 + wr * 64 + fr;
#pragma unroll
        for (int ai = 0; ai < 2; ++ai)
#pragma unroll
            for (int m = 0; m < 4; ++m) { const int r = row0 + ai * 128 + m * 16;
                if (r < T + NMETA) {
                    const float rs = 1.0f / sqrtf(ssq_kv_of(ssqp, r) * (1.f / KVL) + RMS_EPS);
                    int b0, b1, key; if (r < T) { b0 = r >> 11; b1 = b0 + 1; key = NMETA + (r & 2047); } else { b0 = 0; b1 = NB; key = r - T; }
#pragma unroll
                    for (int bj = 0; bj < 2; ++bj) { const int c0 = u.pn * 256 + bj * 128 + wc * 32 + 8 * fq;
                        const f32x4 v0 = acc[ai][bj][m][0] * rs, v1 = acc[ai][bj][m][1] * rs;
                        const int h = c0 >> 7, d0 = c0 & 127;
                        v4u o; o.x = pk2(v0[0], v0[1]); o.y = pk2(v0[2], v0[3]); o.z = pk2(v1[0], v1[1]); o.w = pk2(v1[2], v1[3]);
                        for (int b = b0; b < b1; ++b) *(v4u*)(Kc + (((size_t)b * NH + h) * KPAD + key) * DQK + d0) = o; }
                }
            }
        if (u.pn < 4) {
#pragma unroll
            for (int ai = 0; ai < 2; ++ai) { const int r = row0 + ai * 128 + wc * 16;
                if (r < T + NMETA) {
                    int b0, b1, key; if (r < T) { b0 = r >> 11; b1 = b0 + 1; key = NMETA + (r & 2047); } else { b0 = 0; b1 = NB; key = r - T; }
                    const int h = 2 * u.pn + (fq & 1), half = fq >> 1;
                    const v4u* src = (const v4u*)(proj + (size_t)r * NPROJP + PC_KPE + 32 * half);
                    const f32x4* rp = (const f32x4*)(rope + (size_t)(key * 32 + 16 * half) * 2);
                    v4u o[4];
#pragma unroll
                    for (int q = 0; q < 4; ++q) { const v4u x = src[q]; const f32x4 ra = rp[2 * q], rb = rp[2 * q + 1];
                        const unsigned xs[4] = {x.x, x.y, x.z, x.w}; const float cs[8] = {ra[0], ra[1], ra[2], ra[3], rb[0], rb[1], rb[2], rb[3]}; unsigned ov[4];
#pragma unroll
                        for (int p = 0; p < 4; ++p) { const float x1 = __uint_as_float(xs[p] << 16), x2 = __uint_as_float(xs[p] & 0xffff0000u); const float c = cs[2 * p], sn = cs[2 * p + 1];
                            ov[p] = pk2(x1 * c - x2 * sn, x2 * c + x1 * sn); }
                        o[q].x = ov[0]; o[q].y = ov[1]; o[q].z = ov[2]; o[q].w = ov[3]; }
                    for (int b = b0; b < b1; ++b) { v4u* dst = (v4u*)(Kc + (((size_t)b * NH + h) * KPAD + key) * DQK + 128 + 32 * half);
#pragma unroll
                        for (int q = 0; q < 4; ++q) dst[q] = o[q]; }
                }
            }
        }
    }
};

struct EpiVt { static constexpr bool PERM = true, STAGED = false;
    bf16* Vt; const float* ssqp;
    __device__ __forceinline__ void operator()(const f32x4 (&acc)[2][2][4][2], const pg8::Unit& u, int wr, int wc, int fr, int fq) const {
#pragma unroll
        for (int ai = 0; ai < 2; ++ai)
#pragma unroll
            for (int m = 0; m < 4; ++m) { const int r0 = u.pm * 256 + ai * 128 + wr * 64 + m * 16 + 4 * fq;
                if (r0 < T + NMETA) {
                    f32x4 rs;
#pragma unroll
                    for (int j = 0; j < 4; ++j) rs[j] = 1.0f / sqrtf(ssq_kv_of(ssqp, r0 + j) * (1.f / KVL) + RMS_EPS);
                    int b0, b1, key; if (r0 < T) { b0 = r0 >> 11; b1 = b0 + 1; key = NMETA + (r0 & 2047); } else { b0 = 0; b1 = NB; key = r0 - T; }
                    const int kp = keypos(key);
#pragma unroll
                    for (int bj = 0; bj < 2; ++bj)
#pragma unroll
                        for (int n = 0; n < 2; ++n) { const int cv = u.pn * 256 + bj * 128 + wc * 32 + 8 * (fr >> 2) + 4 * n + (fr & 3); const int h = cv >> 7, d = cv & 127;
                            const f32x4 v = acc[ai][bj][m][n] * rs; v2u o; o.x = pk2(v[0], v[1]); o.y = pk2(v[2], v[3]);
                            for (int b = b0; b < b1; ++b) *(v2u*)(Vt + (((size_t)b * NH + h) * DV + d) * KPAD + kp) = o; }
                }
            }
    }
};

constexpr int CT = 32, CROWS = CT + 30;
__device__ __forceinline__ void conv_unit(LAS unsigned char* lds, int unit, const bf16* proj, const float* dw_w, const float* dw_b, const float* ln_g, const float* ln_b, unsigned char* mix) {
    int tid = my_tid(); asm volatile("" : "+v"(tid));
    const int lane = tid & 63, wave = tid >> 6;
    const int b = unit / (S / CT), s0 = (unit % (S / CT)) * CT, p0 = s0 + NMETA;
    LAS unsigned char* glu = lds; LAS float* red = (LAS float*)(lds + CROWS * 2048);
#pragma unroll 4
    for (int idx = tid; idx < CROWS * 128; idx += NTHR) { const int row = idx >> 7, c8 = idx & 127; const int j = p0 - 30 + row;
        v4u o = {0u, 0u, 0u, 0u};
        if (j >= 0) { const int srow = (j < NMETA) ? (T + j) : (b * S + j - NMETA);
            const v4u a = *(const v4u*)(proj + (size_t)srow * NPROJP + PC_A + 8 * c8), g = *(const v4u*)(proj + (size_t)srow * NPROJP + PC_G + 8 * c8);
            const unsigned av[4] = {a.x, a.y, a.z, a.w}, gv[4] = {g.x, g.y, g.z, g.w}; unsigned ov[4];
#pragma unroll
            for (int p = 0; p < 4; ++p) { const float a0 = __uint_as_float(av[p] << 16), a1 = __uint_as_float(av[p] & 0xffff0000u), g0 = __uint_as_float(gv[p] << 16), g1 = __uint_as_float(gv[p] & 0xffff0000u);
                ov[p] = pk2(a0 * __builtin_amdgcn_rcpf(1.0f + __expf(-g0)), a1 * __builtin_amdgcn_rcpf(1.0f + __expf(-g1))); }
            o.x = ov[0]; o.y = ov[1]; o.z = ov[2]; o.w = ov[3]; }
        *(LAS v4u*)(glu + row * 2048 + c8 * 16) = o; }
    __syncthreads();
    float w0[CW], w1[CW];
#pragma unroll
    for (int w = 0; w < CW; ++w) { const float2 ww = *(const float2*)(dw_w + w * CC + 2 * tid); w0[w] = ww.x; w1[w] = ww.y; }
#pragma unroll
    for (int hf = 0; hf < CT / 16; ++hf) {
        float acc0[16], acc1[16];
        { const float2 bb = *(const float2*)(dw_b + 2 * tid);
#pragma unroll
          for (int t = 0; t < 16; ++t) { acc0[t] = bb.x; acc1[t] = bb.y; } }
        const LAS unsigned char* gl = glu + hf * 16 * 2048;
#pragma unroll
        for (int j = 0; j < 46; ++j) { if ((j & 7) == 0) __builtin_amdgcn_sched_barrier(0);
            const unsigned xv = *(const LAS unsigned*)(gl + j * 2048 + tid * 4); const float x0 = __uint_as_float(xv << 16), x1 = __uint_as_float(xv & 0xffff0000u);
#pragma unroll
            for (int t = 0; t < 16; ++t) { const int w = j - t; if (w >= 0 && w < CW) { acc0[t] += x0 * w0[w]; acc1[t] += x1 * w1[w]; } } }
#pragma unroll
        for (int t = 0; t < 16; ++t) { const float p = wave_sum(acc0[t] + acc1[t]); if (lane == 0) red[t * 8 + wave] = p; }
        __syncthreads();
#pragma unroll
        for (int t = 0; t < 16; ++t) { float sum = 0.f;
#pragma unroll
            for (int w = 0; w < 8; ++w) sum += red[t * 8 + w];
            const float mean = sum * (1.f / CC); acc0[t] -= mean; acc1[t] -= mean; }
#pragma unroll
        for (int t = 0; t < 16; ++t) { const float p = wave_sum(acc0[t] * acc0[t] + acc1[t] * acc1[t]); if (lane == 0) red[128 + t * 8 + wave] = p; }
        __syncthreads();
        const float2 gg = *(const float2*)(ln_g + 2 * tid), bb2 = *(const float2*)(ln_b + 2 * tid);
#pragma unroll
        for (int t = 0; t < 16; ++t) { float sum = 0.f;
#pragma unroll
            for (int w = 0; w < 8; ++w) sum += red[128 + t * 8 + w];
            const float rstd = 1.0f / sqrtf(sum * (1.f / CC) + LN_EPS);
            const float y0 = acc0[t] * rstd * gg.x + bb2.x, y1 = acc1[t] * rstd * gg.y + bb2.y;
            *(unsigned short*)(mix + (size_t)(b * S + s0 + 16 * hf + t) * D + CC + 2 * tid) = (unsigned short)__builtin_amdgcn_cvt_pk_fp8_f32(MIX_S * y0 * __builtin_amdgcn_rcpf(1.0f + __expf(-y0)), MIX_S * y1 * __builtin_amdgcn_rcpf(1.0f + __expf(-y1)), 0, false); }
        __syncthreads();
    }
}

constexpr int ATT_KB = 64 * DQK * 2, ATT_VB = DV * 64 * 2, ATT_VOFF = 2 * ATT_KB;
__device__ __forceinline__ void attn_block(LAS unsigned char* lds, const bf16* Q, const bf16* Kc, const bf16* Vt, unsigned char* mix, int b, int h, int qb) {
    int tid = my_tid(); asm volatile("" : "+v"(tid));
    const int lane = tid & 63, wave = __builtin_amdgcn_readfirstlane(tid >> 6), ql = lane & 15, g = lane >> 4;
    const int s = qb * 128 + wave * 16 + ql, pos = s + NMETA;
    const int pos_lo = qb * 128 + wave * 16 + NMETA, pos_hi = pos_lo + 15;
    bf16x8 qf[6];
    { const bf16* qp = Q + (((size_t)b * NH + h) * S + s) * DQK + 8 * g;
#pragma unroll
      for (int ks = 0; ks < 6; ++ks) qf[ks] = *(const bf16x8*)(qp + 32 * ks); }
    const unsigned char* kbase = (const unsigned char*)(Kc + ((size_t)b * NH + h) * KPAD * DQK);
    const unsigned char* vbase = (const unsigned char*)(Vt + ((size_t)b * NH + h) * DV * KPAD);
    const int nt = 2 * qb + 3;
    unsigned kl[3], vl[2], vg[2];
#pragma unroll
    for (int i = 0; i < 3; ++i) { const int id = tid + 512 * i, row = id / 24, ch = id - row * 24; kl[i] = row * 384 + (((ch & ~7) | ((ch ^ (row >> 1)) & 7)) << 4); }
#pragma unroll
    for (int i = 0; i < 2; ++i) { const int id = tid + 512 * i, d = id >> 3, ch = id & 7; vl[i] = d * 128 + (((ch ^ (d >> 1)) & 7) << 4); vg[i] = d * (KPAD * 2) + ch * 16; }
    v4u kr[3], vr[2];
#define ATT_LOAD(t) do { _Pragma("unroll") for (int i = 0; i < 3; ++i) kr[i] = *(const v4u*)(kbase + (size_t)(t) * ATT_KB + (size_t)(tid + 512 * i) * 16); \
                         _Pragma("unroll") for (int i = 0; i < 2; ++i) vr[i] = *(const v4u*)(vbase + (size_t)(t) * 128 + vg[i]); } while (0)
#define ATT_WRITE(buf) do { _Pragma("unroll") for (int i = 0; i < 3; ++i) *(LAS v4u*)(lds + (buf) * ATT_KB + kl[i]) = kr[i]; \
                            _Pragma("unroll") for (int i = 0; i < 2; ++i) *(LAS v4u*)(lds + ATT_VOFF + (buf) * ATT_VB + vl[i]) = vr[i]; } while (0)
    const int x = (ql >> 1) & 7;
    const unsigned kb0 = ql * 384 + ((g ^ x) << 4), kb1 = kb0 ^ 64u;
    const unsigned vb0 = ql * 128 + ((g ^ x) << 4), vb1 = vb0 ^ 64u;
    f32x4 o[8];
#pragma unroll
    for (int i = 0; i < 8; ++i) o[i] = (f32x4){0.f, 0.f, 0.f, 0.f};
    float m_run = -1e30f, l_run = 0.f;
    ATT_LOAD(0); ATT_WRITE(0);
    __syncthreads();
    for (int t = 0; t < nt; ++t) {
        const int buf = t & 1;
        if (t + 1 < nt) ATT_LOAD(t + 1);
        if (64 * t <= pos_hi) {
            const LAS unsigned char* kt = lds + buf * ATT_KB; const LAS unsigned char* vt = lds + ATT_VOFF + buf * ATT_VB;
            f32x4 sc[4];
#pragma unroll
            for (int kb = 0; kb < 4; ++kb) { sc[kb] = (f32x4){0.f, 0.f, 0.f, 0.f};
#pragma unroll
                for (int ks = 0; ks < 6; ++ks) { const bf16x8 kf = *(const LAS bf16x8*)(kt + ((ks & 1) ? kb1 : kb0) + kb * 6144 + (ks >> 1) * 128);
                    sc[kb] = __builtin_amdgcn_mfma_f32_16x16x32_bf16(kf, qf[ks], sc[kb], 0, 0, 0); } }
            bf16x8 vf[4][2];
#pragma unroll
            for (int db = 0; db < 4; ++db)
#pragma unroll
                for (int k2 = 0; k2 < 2; ++k2) vf[db][k2] = *(const LAS bf16x8*)(vt + (k2 ? vb1 : vb0) + db * 2048);
            if (64 * t + 63 > pos_lo) {
#pragma unroll
                for (int kb = 0; kb < 4; ++kb)
#pragma unroll
                    for (int r = 0; r < 4; ++r) if (64 * t + 16 * kb + 4 * g + r > pos) sc[kb][r] = -1e30f;
            }
            float mx = sc[0][0];
#pragma unroll
            for (int kb = 0; kb < 4; ++kb)
#pragma unroll
                for (int r = 0; r < 4; ++r) mx = fmaxf(mx, sc[kb][r]);
            mx = fmaxf(mx, __shfl_xor(mx, 16)); mx = fmaxf(mx, __shfl_xor(mx, 32));
            const float m_new = fmaxf(m_run, mx);
            const float alpha = __builtin_amdgcn_exp2f(m_run - m_new);
            m_run = m_new;
            float ps = 0.f;
#pragma unroll
            for (int kb = 0; kb < 4; ++kb)
#pragma unroll
                for (int r = 0; r < 4; ++r) { sc[kb][r] = __builtin_amdgcn_exp2f(sc[kb][r] - m_new); ps += sc[kb][r]; }
            l_run = l_run * alpha + ps;
#pragma unroll
            for (int i = 0; i < 8; ++i) o[i] = o[i] * alpha;
            union { v4u u; bf16x8 v; } pf[2];
#pragma unroll
            for (int k2 = 0; k2 < 2; ++k2) { pf[k2].u.x = pg8::cvt_pk_bf16(sc[2 * k2][0], sc[2 * k2][1]); pf[k2].u.y = pg8::cvt_pk_bf16(sc[2 * k2][2], sc[2 * k2][3]);
                pf[k2].u.z = pg8::cvt_pk_bf16(sc[2 * k2 + 1][0], sc[2 * k2 + 1][1]); pf[k2].u.w = pg8::cvt_pk_bf16(sc[2 * k2 + 1][2], sc[2 * k2 + 1][3]); }
#pragma unroll
            for (int db = 0; db < 8; ++db)
#pragma unroll
                for (int k2 = 0; k2 < 2; ++k2) { const bf16x8 vq = (db < 4) ? vf[db & 3][k2] : *(const LAS bf16x8*)(vt + (k2 ? vb1 : vb0) + db * 2048);
                    o[db] = __builtin_amdgcn_mfma_f32_16x16x32_bf16(vq, pf[k2].v, o[db], 0, 0, 0); }
        }
        if (t + 1 < nt) ATT_WRITE(buf ^ 1);
        __syncthreads();
    }
#undef ATT_LOAD
#undef ATT_WRITE
    float l = l_run; l += __shfl_xor(l, 16); l += __shfl_xor(l, 32);
    const float inv = MIX_S / l;
    unsigned char* op = mix + (size_t)(b * S + s) * D + h * DV + 4 * g;
#pragma unroll
    for (int db = 0; db < 8; ++db) { int w = __builtin_amdgcn_cvt_pk_fp8_f32(o[db][0] * inv, o[db][1] * inv, 0, false); w = __builtin_amdgcn_cvt_pk_fp8_f32(o[db][2] * inv, o[db][3] * inv, w, true);
        *(int*)(op + 16 * db) = w; }
}


struct EpiRes { static constexpr bool PERM = false, STAGED = false;
    float* x1; const float* x; const float* lnstat; const float* g; const float* b;
    __device__ __forceinline__ void operator()(const f32x4 (&acc)[2][2][4][2], const pg8::Unit& u, int wr, int wc, int fr, int fq) const {
        const int row0 = u.pm * 256 + wr * 64 + fr, col0 = u.pn * 256 + wc * 32 + 4 * fq;
#pragma unroll
        for (int ai = 0; ai < 2; ++ai)
#pragma unroll
            for (int m = 0; m < 4; ++m) { const int r = row0 + ai * 128 + m * 16; const size_t off = (size_t)r * D + col0;
                const float mean = lnstat[2 * r], rstd = lnstat[2 * r + 1];
#pragma unroll
                for (int bj = 0; bj < 2; ++bj)
#pragma unroll
                    for (int n = 0; n < 2; ++n) { const int c = col0 + bj * 128 + n * 16; const f32x4 xv = *(const f32x4*)(x + off + bj * 128 + n * 16), gg = *(const f32x4*)(g + c), bb = *(const f32x4*)(b + c);
                        const f32x4 hv = (xv - mean) * rstd * gg + bb; *(f32x4*)(x1 + off + bj * 128 + n * 16) = hv * ALPHA + acc[ai][bj][m][n] * (1.0f / (MIX_S * F8_SW)); } }
    }
};
struct EpiSwiglu { static constexpr bool PERM = true, STAGED = false;
    unsigned char* act; const float* b1;
    __device__ __forceinline__ void operator()(const f32x4 (&acc)[2][2][4][2], const pg8::Unit& u, int wr, int wc, int fr, int fq) const {
        const int e = u.pm >> 5, pnl = u.pn & 15; const int row0 = u.pm * 256 + wr * 64 + fr, col0 = 128 * pnl + wc * 32 + 8 * fq;
        const float* bg = b1 + (size_t)e * 4096 + col0; const float* bu = bg + 2048;
        const f32x4 bg0 = *(const f32x4*)bg, bg1 = *(const f32x4*)(bg + 4), bu0 = *(const f32x4*)bu, bu1 = *(const f32x4*)(bu + 4);
#pragma unroll
        for (int ai = 0; ai < 2; ++ai)
#pragma unroll
            for (int m = 0; m < 4; ++m) { float a[8];
#pragma unroll
                for (int n = 0; n < 2; ++n)
#pragma unroll
                    for (int j = 0; j < 4; ++j) { float gv = acc[ai][0][m][n][j] * F8_INV + (n ? bg1[j] : bg0[j]), uv = acc[ai][1][m][n][j] * F8_INV + (n ? bu1[j] : bu0[j]);
                        gv = fminf(gv, SW_LIMIT); uv = fminf(fmaxf(uv, -SW_LIMIT), SW_LIMIT);
                        a[4 * n + j] = (F8_SX * gv) * (uv + 1.0f) * __builtin_amdgcn_rcpf(1.0f + __builtin_amdgcn_exp2f(-SW_ALPHA * 1.4426950408889634f * gv)); }
                int w0 = __builtin_amdgcn_cvt_pk_fp8_f32(a[0], a[1], 0, false); w0 = __builtin_amdgcn_cvt_pk_fp8_f32(a[2], a[3], w0, true);
                int w1 = __builtin_amdgcn_cvt_pk_fp8_f32(a[4], a[5], 0, false); w1 = __builtin_amdgcn_cvt_pk_fp8_f32(a[6], a[7], w1, true);
                v2u o; o.x = (unsigned)w0; o.y = (unsigned)w1;
                *(v2u*)(act + (size_t)(row0 + ai * 128 + m * 16) * DFF + col0) = o; }
    }
};
constexpr int STG_OFF = 131072, STG_BIAS = 17408;
struct EpiEo { static constexpr bool PERM = true, STAGED = true;
    unsigned char* eo; const float* b2; LAS unsigned char* stg;
    __device__ __forceinline__ void pre(const pg8::Unit& u, int ui, int wid, int lane) const {
        if (wid == 0) { const int e = u.pm >> 5, pnl = u.pn & 7;
            __builtin_amdgcn_global_load_lds((const unsigned*)(b2 + (size_t)e * D + 256 * pnl + 4 * lane), (LAS unsigned*)(stg + STG_BIAS + (ui & 1) * 1024), 16, 0, 0); }
    }
    __device__ __forceinline__ void run(const f32x4 (&acc)[2][2][4][2], const pg8::Unit& u, int wr, int wc, int fr, int fq, int tid, int ui) const {
        const int pnl = u.pn & 7;
        const LAS float* bl = (const LAS float*)(stg + STG_BIAS + (ui & 1) * 1024) + wc * 32 + 8 * fq;
        f32x4 bv[2][2];
#pragma unroll
        for (int bj = 0; bj < 2; ++bj)
#pragma unroll
            for (int n = 0; n < 2; ++n) bv[bj][n] = *(const LAS f32x4*)(bl + 128 * bj + 4 * n);
        LAS unsigned char* wp = stg + (32 * wr + fr) * 264 + 32 * wc + 8 * fq;
#pragma unroll
        for (int ai = 0; ai < 2; ++ai)
#pragma unroll
            for (int mp = 0; mp < 2; ++mp) {
#pragma unroll
                for (int mm = 0; mm < 2; ++mm)
#pragma unroll
                    for (int bj = 0; bj < 2; ++bj) { const int m = 2 * mp + mm; const f32x4 v0 = acc[ai][bj][m][0] * F8_INV + bv[bj][0], v1 = acc[ai][bj][m][1] * F8_INV + bv[bj][1];
                        s16x2_t r0 = {0, 0}, r1 = {0, 0};
                        r0 = __builtin_amdgcn_cvt_scalef32_pk_fp8_f32(r0, v0[0], v0[1], 1.0f / F8_SE, false); r0 = __builtin_amdgcn_cvt_scalef32_pk_fp8_f32(r0, v0[2], v0[3], 1.0f / F8_SE, true);
                        r1 = __builtin_amdgcn_cvt_scalef32_pk_fp8_f32(r1, v1[0], v1[1], 1.0f / F8_SE, false); r1 = __builtin_amdgcn_cvt_scalef32_pk_fp8_f32(r1, v1[2], v1[3], 1.0f / F8_SE, true);
                        v2u o; o.x = __builtin_bit_cast(unsigned, r0); o.y = __builtin_bit_cast(unsigned, r1);
                        *(LAS v2u*)(wp + 16 * mm * 264 + 128 * bj) = o; }
                LDS_WAIT(); __builtin_amdgcn_s_barrier();
#pragma unroll
                for (int j = 0; j < 2; ++j) { const int p = tid + 512 * j, rl = p >> 4, c16 = p & 15;
                    const v2u lo = *(const LAS v2u*)(stg + rl * 264 + 16 * c16), hi = *(const LAS v2u*)(stg + rl * 264 + 16 * c16 + 8);
                    v4u o4; o4.x = lo.x; o4.y = lo.y; o4.z = hi.x; o4.w = hi.y;
                    const int grow = u.pm * 256 + 128 * ai + 64 * (rl >> 5) + 16 * (2 * mp + ((rl >> 4) & 1)) + (rl & 15);
                    *(v4u*)(eo + (size_t)grow * D + 256 * pnl + 16 * c16) = o4; }
                if (!(ai == 1 && mp == 1)) { LDS_WAIT(); __builtin_amdgcn_s_barrier(); }
            }
    }
};
struct MoeOrder {
    const LAS int* pre; int G, c, NT, ioff, icnt;
    __device__ bool next(int i, pg8::Unit& u) const {
        if (i >= icnt) return false;
        const int L = (i + ioff) * G + c; if (L >= pre[NE]) return false;
        int e = 0; while (pre[e + 1] <= L) ++e;
        const int idx = L - pre[e], te = (pre[e + 1] - pre[e]) / NT; const int pn = idx / te, mt = idx - pn * te;
        u.pm = e * (CAP / 256) + mt; u.pn = e * NT + pn; return true;
    }
};

constexpr int HS = 2052;
__device__ __forceinline__ void ln1_router_unit(LAS unsigned char* lds, int unit, const float* x1, const float* g1, const float* b1n, const float* wr_, const float* br_,
                                                bf16* h1b, unsigned char* xg, int* cnt, int* r_e, float* r_g, int* r_pos) {
    int tid = my_tid(); asm volatile("" : "+v"(tid));
    const int lane = tid & 63, wave = __builtin_amdgcn_readfirstlane(tid >> 6);
    LAS float* hbuf = (LAS float*)lds; LAS float* part = hbuf + 16 * HS; LAS float* logits = part + 8 * 512;
    LAS int* sel = (LAS int*)(logits + 512); LAS int* rank = sel + 64; LAS int* base = rank + 64;
#pragma unroll 1
    for (int rr = 0; rr < 2; ++rr) { const int rl = 2 * wave + rr; const size_t r = (size_t)unit * 16 + rl;
        f32x4 v[8]; float s = 0.f;
#pragma unroll
        for (int j = 0; j < 8; ++j) { v[j] = *(const f32x4*)(x1 + r * D + 4 * lane + 256 * j); s += (v[j][0] + v[j][1]) + (v[j][2] + v[j][3]); }
        const float mean = wave_sum(s) * (1.f / D); float s2 = 0.f;
#pragma unroll
        for (int j = 0; j < 8; ++j) { v[j] = v[j] - mean; s2 += (v[j][0] * v[j][0] + v[j][1] * v[j][1]) + (v[j][2] * v[j][2] + v[j][3] * v[j][3]); }
        const float rstd = 1.0f / sqrtf(wave_sum(s2) * (1.f / D) + LN_EPS);
#pragma unroll
        for (int j = 0; j < 8; ++j) { const int c = 4 * lane + 256 * j; const f32x4 gg = *(const f32x4*)(g1 + c), bb = *(const f32x4*)(b1n + c);
            const f32x4 y = v[j] * rstd * gg + bb; v2u hb; hb.x = pk2(y[0], y[1]); hb.y = pk2(y[2], y[3]); *(v2u*)(h1b + r * D + c) = hb; *(LAS f32x4*)(hbuf + rl * HS + c) = y; } }
    __syncthreads();
    { const int e15 = lane & 15, kq = lane >> 4; f32x4 a0 = {0.f, 0.f, 0.f, 0.f}, a1 = {0.f, 0.f, 0.f, 0.f};
      const LAS float* hp = hbuf + e15 * HS + 256 * wave + kq; const float* wp = wr_ + (size_t)(256 * wave + kq) * NE + e15;
#pragma unroll 8
      for (int ks = 0; ks < 64; ++ks) { const float av = hp[4 * ks]; const float w0 = wp[(size_t)ks * 4 * NE], w1 = wp[(size_t)ks * 4 * NE + 16];
          a0 = __builtin_amdgcn_mfma_f32_16x16x4f32(av, w0, a0, 0, 0, 0); a1 = __builtin_amdgcn_mfma_f32_16x16x4f32(av, w1, a1, 0, 0, 0); }
#pragma unroll
      for (int q = 0; q < 4; ++q) { part[wave * 512 + (4 * kq + q) * 32 + e15] = a0[q]; part[wave * 512 + (4 * kq + q) * 32 + 16 + e15] = a1[q]; } }
    __syncthreads();
    { float sum = br_[tid & 31];
#pragma unroll
      for (int w = 0; w < 8; ++w) sum += part[w * 512 + tid];
      logits[tid] = sum; }
    __syncthreads();
#pragma unroll 1
    for (int rr = 0; rr < 2; ++rr) { const int rl = 2 * wave + rr; const int r = unit * 16 + rl;
        float val = (lane < NE) ? logits[rl * 32 + (lane & 31)] : -3.0e38f;
        int te[4]; float tv[4];
#pragma unroll
        for (int k = 0; k < 4; ++k) { float m = val;
#pragma unroll
            for (int o = 1; o < 64; o <<= 1) m = fmaxf(m, __shfl_xor(m, o));
            const unsigned long long mask = __ballot(val == m && lane < NE);
            const int e = __ffsll((long long)mask) - 1;
            te[k] = e; tv[k] = m; if (lane == e) val = -3.0e38f; }
        float ex[4], se = 0.f;
#pragma unroll
        for (int k = 0; k < 4; ++k) { ex[k] = expf(tv[k] - tv[0]); se += ex[k]; }
        if (lane == 0) { const float ise = 1.0f / se;
#pragma unroll
            for (int k = 0; k < 4; ++k) { r_e[r * 4 + k] = te[k]; r_g[r * 4 + k] = ex[k] * ise; sel[rl * 4 + k] = te[k]; } } }
    __syncthreads();
    if (wave == 0) { int count = 0;
        for (int i = 0; i < 64; ++i) { const int s_ = sel[i]; if (s_ == lane) { rank[i] = count; ++count; } }
        int bse = 0; if (lane < NE && count > 0) bse = atomicAdd(&cnt[lane * 64], count);
        if (lane < NE) base[lane] = bse; }
    __syncthreads();
#pragma unroll 1
    for (int rr = 0; rr < 2; ++rr) { const int rl = 2 * wave + rr; const int r = unit * 16 + rl;
        int te[4], pos[4];
#pragma unroll
        for (int k = 0; k < 4; ++k) { te[k] = sel[rl * 4 + k]; pos[k] = base[te[k]] + rank[rl * 4 + k]; }
        if (lane == 0) {
#pragma unroll
            for (int k = 0; k < 4; ++k) r_pos[r * 4 + k] = pos[k]; }
#pragma unroll
        for (int j = 0; j < 2; ++j) { const int c = 16 * (lane + 64 * j); v4u o; unsigned ov[4];
#pragma unroll
            for (int q = 0; q < 4; ++q) { const f32x4 y = *(const LAS f32x4*)(hbuf + rl * HS + c + 4 * q) * F8_SX;
                int w = __builtin_amdgcn_cvt_pk_fp8_f32(y[0], y[1], 0, false); w = __builtin_amdgcn_cvt_pk_fp8_f32(y[2], y[3], w, true); ov[q] = (unsigned)w; }
            o.x = ov[0]; o.y = ov[1]; o.z = ov[2]; o.w = ov[3];
#pragma unroll
            for (int k = 0; k < 4; ++k) *(v4u*)(xg + ((size_t)te[k] * CAP + pos[k]) * D + c) = o; } }
    __syncthreads();
}

__device__ __forceinline__ void moe_prefix(LAS int* pre, const int* cnt, int NT, int elo, int ehi, int tid) {
    if (tid < 64) { int nt = 0;
        if (tid < NE && tid >= elo && tid < ehi) nt = ((__hip_atomic_load(&cnt[tid * 64], __ATOMIC_RELAXED, __HIP_MEMORY_SCOPE_AGENT) + 255) >> 8) * NT;
        int incl = nt;
#pragma unroll
        for (int o = 1; o < 32; o <<= 1) { const int t = __shfl_up(incl, o); if (tid >= o) incl += t; }
        if (tid < NE) pre[tid] = incl - nt;
        if (tid == NE - 1) pre[NE] = incl; }
}

__global__ void __launch_bounds__(NTHR, 2) mk_fwd(Args args) {
    LAS unsigned char* lds = (LAS unsigned char*)lds_raw;
    volatile LAS unsigned* MISC = (volatile LAS unsigned*)(lds + MISC_OFF);
    for (int u = threadIdx.x; u < (LDS_BYTES - MISC_OFF) / 4; u += NTHR) ((LAS unsigned*)(lds + MISC_OFF))[u] = 0u;
    __syncthreads();
    if ((threadIdx.x & 63) == 0) ((LAS int*)(lds + TIDTAB_OFF))[hw_slot()] = threadIdx.x >> 6;
    __syncthreads();
    const int wave = __builtin_amdgcn_readfirstlane(my_tid() >> 6);
    const int G = gridDim.x; const int bx = blockIdx.x; const int vcu = (G % 8 == 0) ? (bx % 8) * (G / 8) + bx / 8 : bx;
    unsigned char* ws = args.ws;
    unsigned* ctl = (unsigned*)(ws + WS_CTL);
    const int lo = args.ph_lo, hi = args.ph_hi;
    const bool multi = (hi - lo) > 1;
    XcdBarrier bar; bar.bar = ctl + CW_BAR; bar.x = 0; bar.st = nullptr;
    if (multi) bar = xcd_barrier_post(ctl + CW_BAR, MISC + 8);
#define IN(k) (lo <= (k) && (k) < hi)
#define SEAM(k) do { if (IN(k) && IN((k) + 1)) xcd_barrier(bar); } while (0)
    bf16* wt_uq = (bf16*)(ws + WS_WTUQ); bf16* wt_kv = (bf16*)(ws + WS_WTKV); bf16* wt_out = (bf16*)(ws + WS_WTOUT);
    unsigned char* h0b8 = ws + WS_H0B; unsigned char* wt_in8 = ws + WS_WTIN; float* rsc = (float*)(ws + WS_RSC); float* csc = (float*)(ws + WS_CSC); bf16* proj = (bf16*)(ws + WS_PROJ);
    float* rope = (float*)(ws + WS_ROPE);
    float* ssqp = (float*)(ws + WS_SSQP); float* lnstat = (float*)(ctl + CW_LNSTAT);
    const int gw = vcu * NWAVES + wave, NGW = G * NWAVES;
    const int cvA = (G == 256) ? CONV_P1 : 0, cvB = cvA + CONV_P3_PER_WAVE * NGW, cvC = cvB + CONV_P2_PER_WAVE * NGW, cvD = cvC + CONV_P4_PER_WAVE * NGW, cvE = cvD + CONV_P5_PER_WAVE * NGW;
#define HOST_CONV(lo, hi) do { __syncthreads(); conv_items((lo) + gw, (hi), NGW, args.in[19], args.in[21], ws + WS_WT1, ws + WS_WT2, lds + wave * 16384, my_lane()); __syncthreads(); } while (0)
    const unsigned hslot = (((unsigned)vcu * 2654435761u) >> 11);

    if (IN(0)) {
        const int lane = my_lane(), tid = wave * 64 + lane;
        LAS float* scr = (LAS float*)(lds + wave * 16384);
        constexpr int F_UQ = 32 * (QL / 128), F_KV = 64 * (KVL / 128), F_OUT = 64 * (D / 128), NFAST = F_UQ + F_KV + F_OUT;
        constexpr int S_UQ = 16 * (QL / 64), NSLOW = S_UQ;
        LAS unsigned char* dtile = lds + wave * 16384;
        for (int nbk = vcu; nbk < NPROJP / 32; nbk += G) wtin_block(lds, nbk, args.in[4], wt_in8, csc, tid);
        const int gw2 = (G > NPROJP / 32) ? ((vcu + G - NPROJP / 32) % G) * NWAVES + wave : gw;
        for (int it = gw2; it < NFAST + NSLOW; it += NGW) {
            int r = it;
            if (r < F_UQ) { const int nbq = r % 32, kb = r / 32; const int col = (nbq >> 2) * DQK + 32 * (nbq & 3); tb16_item(args.in[6], 1536, QL, wt_uq, col, col, 128 * kb, args.in[5], dtile, lane); continue; } r -= F_UQ;
            if (r < F_KV) { const int nb = r % 64, kb = r / 64;
                if (nb < 32) tb16_item(args.in[8], 1024, KVL, wt_kv, 32 * nb, 32 * nb, 128 * kb, args.in[7], dtile, lane);
                else tb16_item(args.in[9], 1024, KVL, wt_kv + (size_t)1024 * KVL, 32 * (nb - 32), 32 * (nb - 32), 128 * kb, args.in[7], dtile, lane);
                continue; } r -= F_KV;
            if (r < F_OUT) { const int nb = r % 64, kb = r / 64;
                TI64 t; t.ldw = D; t.K = D; t.src = args.in[14] + (size_t)(128 * kb + (lane >> 3)) * D + 32 * nb + 4 * (lane & 7); t.dst = (unsigned char*)wt_out + (size_t)(32 * nb) * D + 128 * kb;
                f32x4 v[16]; ti64_load(t, v); ti64_store(t, v, dtile, lane); continue; } r -= F_OUT;
            { const int j = r & 15, kb = r >> 4; const int n0 = (j >> 1) * DQK + 128 + 32 * (j & 1); transpose_item(args.in[6], 1536, QL, wt_uq, n0, 64 * kb, SC_uq{}, args.in[5], scr, lane); }
        }
        {
            unsigned char* wt1 = ws + WS_WT1; unsigned char* wt2 = ws + WS_WT2;
            constexpr int NIT = NE * ((D / 128) * (4096 / 32) + (DFF / 128) * (D / 32));
            LAS unsigned char* tile = lds + wave * 16384;
            conv_items(cvE + gw2, CONV_W2, NGW, args.in[19], args.in[21], wt1, wt2, tile, lane);
        }
        for (int r = gw; r < MROWS; r += NGW) {
            if (r < T) ln_row8(args.in[0] + (size_t)r * D, args.in[2], args.in[3], lnstat + 2 * r, h0b8 + (size_t)r * D, rsc + r, lane);
            else if (r < T + NMETA) ln_row8(args.in[1] + (size_t)(r - T) * D, args.in[2], args.in[3], nullptr, h0b8 + (size_t)r * D, rsc + r, lane);
            else { if (lane == 0) rsc[r] = 0.f;
#pragma unroll
                for (int j = 0; j < 8; ++j) *(unsigned*)(h0b8 + (size_t)r * D + 4 * lane + 256 * j) = 0u; }
        }
        for (int idx = (bx * NTHR + tid); idx < LSEQ * 32; idx += G * NTHR) {
            const int pos = idx / 32, i = idx % 32;
            const float inv = 1.0f / powf(10000.0f, (float)(2 * i) / 64.0f);
            const float f = (float)pos * inv;
            rope[2 * idx] = (float)cos((double)f); rope[2 * idx + 1] = (float)sin((double)f);
        }
    }
    SEAM(0);
    if (IN(1)) {
        pg8::Gemm g{(const bf16*)h0b8, (const bf16*)wt_in8, D / 2, D / 2, D / 2}; pg8::StaticOrder S; S.init(MROWS / 256, NPROJP / 256, G, bx);
        EpiProj E{proj, ssqp, rsc, csc};
        pg8::gemm_phase<EpiProj, pg8::StaticOrder, true, true, false, false, true>(lds, g, S, E);
        if (G == 256 && bx >= 206) {
            __syncthreads();
            conv_items((bx - 206) * NWAVES + wave, CONV_P1, 50 * NWAVES, args.in[19], args.in[21], ws + WS_WT1, ws + WS_WT2, lds + wave * 16384, my_lane());
        }
    }
    SEAM(1);
    if (IN(2)) {
        bf16* Q = (bf16*)(ws + WS_Q); bf16* Kc = (bf16*)(ws + WS_K); bf16* Vt = (bf16*)(ws + WS_V); unsigned char* mix = ws + WS_MIX;
        const unsigned s2 = hslot % 4u;
        if (s2 == 0) HOST_CONV(cvB, cvC);
        { pg8::Gemm g{proj + PC_Q, wt_uq, QL, NPROJP, QL}; pg8::StaticOrder S; S.init(T / 256, 1536 / 256, G, bx);
          EpiQ E{Q, ssqp, rope};
          pg8::gemm_phase<EpiQ, pg8::StaticOrder, true, true>(lds, g, S, E); }
        if (s2 == 1) HOST_CONV(cvB, cvC);
        { pg8::Gemm g{proj + PC_KV, wt_kv, KVL, NPROJP, KVL}; pg8::StaticOrder S; S.init(MROWS / 256, 1024 / 256, G, G == 256 ? (bx + 64) % G : bx);
          EpiKV E{Kc, Vt, ssqp, proj, rope};
          pg8::gemm_phase<EpiKV, pg8::StaticOrder, true, true>(lds, g, S, E); }
        if (s2 == 2) HOST_CONV(cvB, cvC);
        { pg8::Gemm g{proj + PC_KV, wt_kv + (size_t)1024 * KVL, KVL, NPROJP, KVL}; pg8::StaticOrder S; S.init(MROWS / 256, 1024 / 256, G, G == 256 ? (bx >= 192 ? bx - 192 : ((bx >= 68 && bx < 136) ? bx - 4 : 100000)) : G - 1 - bx);
          EpiVt E{Vt, ssqp};
          pg8::gemm_phase<EpiVt, pg8::StaticOrder, true, true, false, true>(lds, g, S, E); }
        if (s2 == 3) HOST_CONV(cvB, cvC);
        __syncthreads();
        for (int u = bx; u < T / CT; u += G) conv_unit(lds, u, proj, args.in[10], args.in[11], args.in[12], args.in[13], mix);
    }
    SEAM(2);
    if (IN(3)) {
        const bf16* Q = (const bf16*)(ws + WS_Q); const bf16* Kc = (const bf16*)(ws + WS_K); const bf16* Vt = (const bf16*)(ws + WS_V); unsigned char* mix = ws + WS_MIX;
        for (int pi = vcu; pi < NB * NH * 8; pi += G) { const int bh = pi >> 3, p = pi & 7;
            const int slot8 = (int)((((unsigned)vcu * 2654435761u) >> 13) % 8u); const int slot = slot8 < 3 ? 0 : (slot8 < 6 ? 1 : 2);
#define ATT_CONV() do { __syncthreads(); conv_items(cvA + gw, cvB, NGW, args.in[19], args.in[21], ws + WS_WT1, ws + WS_WT2, lds + wave * 16384, my_lane()); __syncthreads(); } while (0)
            if (slot == 0) ATT_CONV();
            attn_block(lds, Q, Kc, Vt, mix, bh >> 3, bh & 7, 15 - p);
            if (slot == 1) ATT_CONV();
            attn_block(lds, Q, Kc, Vt, mix, bh >> 3, bh & 7, p);
            if (slot == 2) ATT_CONV();
#undef ATT_CONV
        }
        if (vcu >= NB * NH * 8) { __syncthreads(); conv_items(cvA + gw, cvB, NGW, args.in[19], args.in[21], ws + WS_WT1, ws + WS_WT2, lds + wave * 16384, my_lane()); }
    }
    SEAM(3);
    if (IN(4)) {
        pg8::Gemm g{(const bf16*)(ws + WS_MIX), wt_out, D / 2, D / 2, D / 2}; pg8::StaticOrder S; S.init(T / 256, D / 256, G, bx);
        EpiRes E{(float*)(ws + WS_X1), args.in[0], lnstat, args.in[2], args.in[3]};
        if ((hslot & 1u) == 0u) HOST_CONV(cvC, cvD);
        pg8::gemm_phase<EpiRes, pg8::StaticOrder, true, true, true>(lds, g, S, E);
        if ((hslot & 1u) == 1u) HOST_CONV(cvC, cvD);
    }
    SEAM(4);
    int* cnt = (int*)(ctl + CW_CNT);
    int* r_e = (int*)(ws + WS_ROUTE); float* r_g = (float*)(ws + WS_ROUTE + 256 * 1024); int* r_pos = (int*)(ws + WS_ROUTE + 512 * 1024);
    bf16* h1b = (bf16*)(ws + WS_H1B); unsigned char* xg = ws + WS_XG; unsigned char* act = ws + WS_ACT; unsigned char* eo = ws + WS_EO;
    if (IN(5)) {
        const unsigned s5 = hslot % 3u; int ui5 = 0;
        if (s5 == 0) HOST_CONV(cvD, cvE);
        for (int u = bx; u < T / 16; u += G) { ln1_router_unit(lds, u, (const float*)(ws + WS_X1), args.in[15], args.in[16], args.in[17], args.in[18], h1b, xg, cnt, r_e, r_g, r_pos);
            if (++ui5 == 1 && s5 == 1) HOST_CONV(cvD, cvE); }
        if (s5 == 2 || (s5 == 1 && ui5 == 0)) HOST_CONV(cvD, cvE);
    }
    SEAM(5);
    LAS int* pre = (LAS int*)(lds + MISC_OFF + 256);
#define MOE1_STAGE(elo, ehi, cfirst, cend) do { \
        __syncthreads(); \
        moe_prefix(pre, cnt, 16, (elo), (ehi), wave * 64 + my_lane()); \
        __syncthreads(); \
        const int nun = pre[NE]; const int mine = (nun > vcu) ? (nun - vcu + G - 1) / G : 0; \
        const int kbrk = (int)((((unsigned)vcu * 2654435761u) >> 16) % (unsigned)(mine + 1)); \
        pg8::Gemm g{(const bf16*)xg, (const bf16*)(ws + WS_WT1), D / 2, D / 2, D / 2}; EpiSwiglu E{act, args.in[20]}; \
        { MoeOrder S{pre, G, vcu, 16, 0, kbrk}; pg8::gemm_phase<EpiSwiglu, MoeOrder, true, true, true>(lds, g, S, E); } \
        __syncthreads(); \
        conv_items((cfirst) + gw, (cend), NGW, args.in[19], args.in[21], ws + WS_WT1, ws + WS_WT2, lds + wave * 16384, my_lane()); \
        __syncthreads(); \
        { MoeOrder S{pre, G, vcu, 16, kbrk, mine - kbrk}; pg8::gemm_phase<EpiSwiglu, MoeOrder, true, true, true>(lds, g, S, E); } \
    } while (0)
    if (IN(6)) MOE1_STAGE(0, NE, CONV_W2, CONV_END);
    SEAM(6);
#undef MOE1_STAGE
    if (IN(7)) {
        __syncthreads();
        moe_prefix(pre, cnt, 8, 0, NE, wave * 64 + my_lane());
        __syncthreads();
        pg8::Gemm g{(const bf16*)act, (const bf16*)(ws + WS_WT2), DFF / 2, DFF / 2, DFF / 2}; MoeOrder S{pre, G, vcu, 8, 0, 1 << 30};
        EpiEo E{eo, args.in[22], lds + STG_OFF};
        pg8::gemm_phase<EpiEo, MoeOrder, true, true, true>(lds, g, S, E);
    }
    SEAM(7);
    if (IN(8)) {
        const int lane = my_lane();
        for (int r = gw; r < T; r += NGW) {
            f32x4 v[8];
#pragma unroll
            for (int j = 0; j < 8; ++j) { const v2u x = *(const v2u*)(h1b + (size_t)r * D + 4 * lane + 256 * j);
                v[j][0] = ALPHA * __uint_as_float(x.x << 16); v[j][1] = ALPHA * __uint_as_float(x.x & 0xffff0000u); v[j][2] = ALPHA * __uint_as_float(x.y << 16); v[j][3] = ALPHA * __uint_as_float(x.y & 0xffff0000u); }
#pragma unroll
            for (int k = 0; k < 4; ++k) { const float gk = r_g[r * 4 + k] * (1.0f / F8_SE); const unsigned char* src = eo + ((size_t)r_e[r * 4 + k] * CAP + r_pos[r * 4 + k]) * D;
#pragma unroll
                for (int j = 0; j < 8; ++j) { const int x = *(const int*)(src + 4 * lane + 256 * j);
                    const pg8::f32x2v lo = __builtin_amdgcn_cvt_pk_f32_fp8(x, false), hi = __builtin_amdgcn_cvt_pk_f32_fp8(x, true);
                    v[j][0] += gk * lo[0]; v[j][1] += gk * lo[1]; v[j][2] += gk * hi[0]; v[j][3] += gk * hi[1]; } }
            float s_ = 0.f;
#pragma unroll
            for (int j = 0; j < 8; ++j) s_ += (v[j][0] + v[j][1]) + (v[j][2] + v[j][3]);
            const float mean = wave_sum(s_) * (1.f / D); float s2 = 0.f;
#pragma unroll
            for (int j = 0; j < 8; ++j) { v[j] = v[j] - mean; s2 += (v[j][0] * v[j][0] + v[j][1] * v[j][1]) + (v[j][2] * v[j][2] + v[j][3] * v[j][3]); }
            const float rstd = 1.0f / sqrtf(wave_sum(s2) * (1.f / D) + LN_EPS);
#pragma unroll
            for (int j = 0; j < 8; ++j) { const int c = 4 * lane + 256 * j; const f32x4 gg = *(const f32x4*)(args.in[23] + c), bb = *(const f32x4*)(args.in[24] + c);
                *(f32x4*)(args.out + (size_t)r * D + c) = v[j] * rstd * gg + bb; }
        }
    }
#undef HOST_CONV
#undef IN
#undef SEAM
}

static int mk_grid = 0;
static void mk_launch(Args a, int lo, int hi, hipStream_t stream) {
    if (mk_grid == 0) {
        int dev = 0, cus = 0;
        (void)hipGetDevice(&dev); (void)hipDeviceGetAttribute(&cus, hipDeviceAttributeMultiprocessorCount, dev);
        if (hipFuncSetAttribute((const void*)mk_fwd, hipFuncAttributeMaxDynamicSharedMemorySize, LDS_BYTES) != hipSuccess) fprintf(stderr, "hipFuncSetAttribute failed\n");
        int per_cu = 0; (void)hipOccupancyMaxActiveBlocksPerMultiprocessor(&per_cu, (const void*)mk_fwd, NTHR, LDS_BYTES);
        if (per_cu < 1) fprintf(stderr, "occupancy query says %d\n", per_cu);
        (void)hipGetLastError();
        mk_grid = cus > 0 ? cus : 256;
    }
    a.ph_lo = lo; a.ph_hi = hi;
    hipLaunchKernelGGL(mk_fwd, dim3(mk_grid), dim3(NTHR), LDS_BYTES, stream, a);
}

extern "C" void kernel_launch(void* const* d_in, const int* in_sizes, int n_in, void* d_out, int out_size, void* d_ws, size_t ws_size, hipStream_t stream) {
    if (n_in != 25 || ws_size < WS_END) { fprintf(stderr, "kernel_launch: unexpected n_in %d or ws %zu\n", n_in, ws_size); return; }
    unsigned char* ws = (unsigned char*)d_ws;
    (void)hipMemsetAsync(ws + WS_CTL, 0, CTL_BYTES, stream);
    Args a{}; for (int i = 0; i < 25; ++i) a.in[i] = (const float*)d_in[i]; a.out = (float*)d_out; a.ws = ws;
    mk_launch(a, 0, 9, stream);
}
```

```cpp
#include <hip/hip_runtime.h>
#include <cstdio>
#include <cstdint>

typedef unsigned short bf16;
typedef __bf16 bf16x2v __attribute__((ext_vector_type(2)));
__device__ __forceinline__ float bf2f(bf16 v) { return __uint_as_float(((unsigned)v) << 16); }
__device__ __forceinline__ bf16 f2bf(float f) { unsigned u = __float_as_uint(f); return (bf16)((u + 0x7fffu + ((u >> 16) & 1u)) >> 16); }

constexpr int D = 2048, NB = 4, S = 2048, NMETA = 16, LSEQ = S + NMETA;
constexpr int T = NB * S;
constexpr int MROWS = 8448;
constexpr int NH = 8, DQK = 192, DNOPE = 128, DROPE = 64, DV = 128;
constexpr int QL = 768, KVL = 512, CC = 1024, CW = 31;
constexpr int NPROJ = 3392, NPROJP = 3584;
constexpr int PC_Q = 0, PC_KV = 768, PC_A = 1280, PC_G = 2304, PC_KPE = 3328;
constexpr int NE = 32, TOPK = 4, DFF = 2048, CAP = 8192;
constexpr int KPAD = 2112;
constexpr float ALPHA = 1.189207115002721f;
constexpr float LN_EPS = 1e-5f, RMS_EPS = 1e-6f;
constexpr float SW_LIMIT = 7.0f, SW_ALPHA = 1.702f;

constexpr size_t MiB = 1ull << 20;
constexpr size_t WS_CTL = 0, CTL_BYTES = 64 * 1024;
constexpr size_t WS_ROPE = 1 * MiB;
constexpr size_t WS_WTIN = 2 * MiB, WS_WTUQ = 18 * MiB, WS_WTKV = 21 * MiB, WS_WTOUT = 23 * MiB;
constexpr size_t WS_RSC = 48 * MiB, WS_CSC = 49 * MiB;
constexpr size_t WS_SSQP = 32 * MiB, WS_H0B = 96 * MiB, WS_PROJ = 130 * MiB, WS_Q = 188 * MiB, WS_K = 212 * MiB, WS_V = 237 * MiB;
constexpr size_t WS_MIX = 254 * MiB, WS_X1 = 286 * MiB, WS_H1B = 350 * MiB, WS_ROUTE = 414 * MiB;
constexpr size_t WS_WT1 = 416 * MiB, WS_WT2 = 672 * MiB, WS_XG = 800 * MiB, WS_ACT = 1312 * MiB, WS_EO = 1824 * MiB, WS_END = 2848 * MiB;
constexpr float F8_SX = 4.0f, F8_SW = 256.0f, F8_INV = 1.0f / (F8_SX * F8_SW), F8_SE = 64.0f;
constexpr int CW_CNT = 8192;
constexpr int CW_LNSTAT = 65536;

__device__ __forceinline__ int proj_src_col(int np) {
    if (np < 1280) return np;
    if (np < 3328) return np + 64;
    if (np < 3392) { const int i = np - 3328; return 1280 + (i >> 1) + 32 * (i & 1); }
    return -1;
}

__host__ __device__ __forceinline__ int keypos(int key) { return (key & ~31) | ((key & 0x0C) << 1) | ((key & 0x10) >> 2) | (key & 3); }

__device__ __forceinline__ float wave_sum(float v) {
#pragma unroll
    for (int o = 1; o < 64; o <<= 1) v += __shfl_xor(v, o);
    return v;
}

typedef float f32x4_t __attribute__((ext_vector_type(4)));
typedef unsigned u32x2_t __attribute__((ext_vector_type(2)));
__device__ __forceinline__ unsigned pk2_rne(float lo, float hi) { return (unsigned)f2bf(lo) | ((unsigned)f2bf(hi) << 16); }
__device__ __forceinline__ void ln_row(const float* src, const float* g, const float* b, float* stats2, bf16* dstb, int lane) {
    f32x4_t v[8]; float s = 0.f;
#pragma unroll
    for (int j = 0; j < 8; ++j) { v[j] = *(const f32x4_t*)(src + 4 * lane + 256 * j); s += (v[j][0] + v[j][1]) + (v[j][2] + v[j][3]); }
    const float mean = wave_sum(s) * (1.f / D); float s2 = 0.f;
#pragma unroll
    for (int j = 0; j < 8; ++j) { v[j] = v[j] - mean; s2 += (v[j][0] * v[j][0] + v[j][1] * v[j][1]) + (v[j][2] * v[j][2] + v[j][3] * v[j][3]); }
    const float rstd = 1.0f / sqrtf(wave_sum(s2) * (1.f / D) + LN_EPS);
    if (stats2 && lane == 0) { stats2[0] = mean; stats2[1] = rstd; }
#pragma unroll
    for (int j = 0; j < 8; ++j) { const int c = 4 * lane + 256 * j; const f32x4_t gg = *(const f32x4_t*)(g + c), bb = *(const f32x4_t*)(b + c);
        const f32x4_t o = v[j] * rstd * gg + bb; u32x2_t w; w.x = pk2_rne(o[0], o[1]); w.y = pk2_rne(o[2], o[3]); *(u32x2_t*)(dstb + c) = w; }
}

__device__ __forceinline__ float wave_max(float v) {
#pragma unroll
    for (int o = 32; o > 0; o >>= 1) v = fmaxf(v, __shfl_xor(v, o));
    return v;
}
__device__ __forceinline__ unsigned pack_i8x4(float a, float b, float c, float d) {
    const int ia = (int)a, ib = (int)b, ic = (int)c, id = (int)d;
    return (unsigned)(ia & 255) | ((unsigned)(ib & 255) << 8) | ((unsigned)(ic & 255) << 16) | ((unsigned)id << 24);
}
__device__ __forceinline__ void ln_row8(const float* src, const float* g, const float* b, float* stats2, unsigned char* dst8, float* rsc, int lane) {
    f32x4_t v[8]; float s = 0.f;
#pragma unroll
    for (int j = 0; j < 8; ++j) { v[j] = *(const f32x4_t*)(src + 4 * lane + 256 * j); s += (v[j][0] + v[j][1]) + (v[j][2] + v[j][3]); }
    const float mean = wave_sum(s) * (1.f / D); float s2 = 0.f;
#pragma unroll
    for (int j = 0; j < 8; ++j) { v[j] = v[j] - mean; s2 += (v[j][0] * v[j][0] + v[j][1] * v[j][1]) + (v[j][2] * v[j][2] + v[j][3] * v[j][3]); }
    const float rstd = 1.0f / sqrtf(wave_sum(s2) * (1.f / D) + LN_EPS);
    if (stats2 && lane == 0) { stats2[0] = mean; stats2[1] = rstd; }
    float am = 0.f;
#pragma unroll
    for (int j = 0; j < 8; ++j) { const int c = 4 * lane + 256 * j; const f32x4_t gg = *(const f32x4_t*)(g + c), bb = *(const f32x4_t*)(b + c);
        v[j] = v[j] * rstd * gg + bb; am = fmaxf(fmaxf(am, fmaxf(fabsf(v[j][0]), fabsf(v[j][1]))), fmaxf(fabsf(v[j][2]), fabsf(v[j][3]))); }
    am = wave_max(am);
    const float inv = am > 0.f ? 127.0f / am : 0.f;
    if (lane == 0) *rsc = am * (1.0f / 127.0f);
#pragma unroll
    for (int j = 0; j < 8; ++j) { const f32x4_t q = v[j] * inv; *(unsigned*)(dst8 + 4 * lane + 256 * j) = pack_i8x4(rintf(q[0]), rintf(q[1]), rintf(q[2]), rintf(q[3])); }
}

constexpr float MIX_S = 16.0f;
constexpr float QSCALE = 0.07216878364870323f * 1.4426950408889634f;

constexpr int TIDTAB_OFF = 153600 + 1024;
extern __shared__ __attribute__((aligned(16))) unsigned char lds_raw[];
__device__ __forceinline__ int hw_slot() { return (int)(__builtin_amdgcn_s_getreg((5 << 11) | 4) & 63u); }
__device__ __forceinline__ int my_lane() { int l; asm volatile("v_mbcnt_lo_u32_b32 %0, -1, 0\n\tv_mbcnt_hi_u32_b32 %0, -1, %0" : "=v"(l)); return l; }
__device__ __forceinline__ int my_tid() {
    const int wv = ((const __attribute__((address_space(3))) int*)((__attribute__((address_space(3))) unsigned char*)lds_raw + TIDTAB_OFF))[hw_slot()];
    return __builtin_amdgcn_readfirstlane(wv) * 64 + my_lane();
}
namespace pg8 {
#define PG8_LAS __attribute__((address_space(3)))
typedef unsigned short bf16_t;
typedef short bf16x8 __attribute__((ext_vector_type(8)));
typedef float f32x4 __attribute__((ext_vector_type(4)));
typedef unsigned u32x4 __attribute__((ext_vector_type(4)));
constexpr int BM = 256, BK = 64, HALF = 128, HTB = HALF * BK * 2, STAGE_BYTES = 8 * HTB, NXCD = 8, WGM = 8;

__host__ __device__ __forceinline__ int lds_byte(int r, int c) { const int st = (r >> 4) * 2 + (c >> 5), rr = r & 15, cc = c & 31, ob = rr * 64 + cc * 2; return st * 1024 + (ob ^ (((ob >> 9) & 1) << 5)); }
__host__ __device__ __forceinline__ void stage_rc(int b, int& R, int& C) { const int st = b / 1024, sb = b % 1024, swz = sb ^ (((sb >> 9) & 1) << 5); R = (st >> 1) * 16 + swz / 64; C = (st & 1) * 32 + (swz % 64) / 2; }
__host__ __device__ __forceinline__ int perm32(int rho) { const int n = rho >> 4, i = rho & 15; return 8 * (i >> 2) + 4 * n + (i & 3); }

struct Unit { int pm, pn; };
struct Gemm { const bf16_t* A; const bf16_t* Bt; int K, lda, ldb; };

struct StaticOrder {
    int nM, nN, nwg, G, c;
    __device__ void init(int nM_, int nN_, int G_, int c_) { nM = nM_; nN = nN_; nwg = nM * nN; G = G_; c = c_; }
    __device__ bool next(int i, Unit& u) const {
        const long L = (long)i * G + c; if (L >= nwg) return false;
        int wgid = (int)L; { const int q = nwg / NXCD, r = nwg % NXCD, xcd = wgid % NXCD, off = wgid / NXCD; wgid = (xcd < r ? xcd * (q + 1) : r * (q + 1) + (xcd - r) * q) + off; }
        const int nig = WGM * nN, gid = wgid / nig, fm = gid * WGM, gsz = (nM - fm) < WGM ? (nM - fm) : WGM;
        u.pm = fm + ((wgid % nig) % gsz); u.pn = (wgid % nig) / gsz; return true;
    }
};

typedef float f32x2v __attribute__((ext_vector_type(2)));
__device__ __forceinline__ unsigned cvt_pk_bf16(float lo, float hi) { const f32x2v f = {lo, hi}; const bf16x2v b = __builtin_convertvector(f, bf16x2v); return __builtin_bit_cast(unsigned, b); }

typedef int v8i_t __attribute__((ext_vector_type(8)));
typedef int v4i_t __attribute__((ext_vector_type(4)));
template <class Epi, class Sched, bool ALIGN_EPI = false, bool SP2 = false, bool F8 = false, bool SWAP = false, bool I8 = false>
__device__ __forceinline__ void gemm_phase(PG8_LAS unsigned char* lds, const Gemm g, const Sched& S, const Epi& E) {
    const int tid = my_tid(), wid = __builtin_amdgcn_readfirstlane(tid >> 6), lane = tid & 63, wr = wid >> 2, wc = wid & 3, fr = lane & 15, fq = lane >> 4;
    const int K = g.K, nt = K / BK;
    unsigned voffA[2], voffB[2];
#pragma unroll
    for (int i = 0; i < 2; ++i) { int R, C; stage_rc(tid * 16 + i * 8192, R, C); const int Rb = Epi::PERM ? ((R & ~31) + perm32(R & 31)) : R;
        voffA[i] = (unsigned)(R * g.lda + C) * 2u; voffB[i] = (unsigned)(Rb * g.ldb + C) * 2u; }
    const size_t kstep = (size_t)(BK * 2);
    const size_t hstepA = (size_t)HALF * g.lda * 2, hstepB = (size_t)HALF * g.ldb * 2;
    const size_t tstepA = 2 * hstepA, tstepB = 2 * hstepB;
    const unsigned ldsw = (unsigned)wid * 1024u;
    const int aoff = lds_byte(wr * 64 + fr, fq * 8), boff = lds_byte(wc * 32 + fr, fq * 8);
#define PG8_SA(b, h) (((b) * 2 + (h)) * HTB)
#define PG8_SB(b, h) ((4 + (b) * 2 + (h)) * HTB)
#define PG8_STAGE(bufoff, gbase, voff) do { _Pragma("unroll") for (int _i = 0; _i < 2; ++_i) \
        __builtin_amdgcn_global_load_lds((const unsigned*)((const char*)(gbase) + (voff)[_i]), (PG8_LAS unsigned*)(lds + (bufoff) + ldsw + _i * 8192), 16, 0, 0); } while (0)
#define PG8_LDA(dst, b, h) do { _Pragma("unroll") for (int m = 0; m < 4; ++m) _Pragma("unroll") for (int k = 0; k < 2; ++k) dst[m][k] = *(const PG8_LAS bf16x8*)(lds + PG8_SA(b, h) + aoff + m * 2048 + k * 1024); } while (0)
#define PG8_LDB(dst, b, h) do { _Pragma("unroll") for (int n = 0; n < 2; ++n) _Pragma("unroll") for (int k = 0; k < 2; ++k) dst[n][k] = *(const PG8_LAS bf16x8*)(lds + PG8_SB(b, h) + boff + n * 2048 + k * 1024); } while (0)
#define PG8_MMA(ai, bj, At, Bt) do { __builtin_amdgcn_s_setprio(1); \
        if constexpr (F8) { _Pragma("unroll") for (int m = 0; m < 4; ++m) _Pragma("unroll") for (int n = 0; n < 2; ++n) \
            asm volatile("v_mfma_scale_f32_16x16x128_f8f6f4 %0, %1, %2, %0, %3, %3 op_sel_hi:[0,0,0]" : "+v"(acc[ai][bj][m][n]) \
                : "v"(__builtin_shufflevector(__builtin_bit_cast(v4i_t, Bt[n][0]), __builtin_bit_cast(v4i_t, Bt[n][1]), 0, 1, 2, 3, 4, 5, 6, 7)), \
                  "v"(__builtin_shufflevector(__builtin_bit_cast(v4i_t, At[m][0]), __builtin_bit_cast(v4i_t, At[m][1]), 0, 1, 2, 3, 4, 5, 6, 7)), "v"(f8scale)); } \
        else if constexpr (I8) { _Pragma("unroll") for (int m = 0; m < 4; ++m) _Pragma("unroll") for (int n = 0; n < 2; ++n) _Pragma("unroll") for (int k = 0; k < 2; ++k) \
            acc[ai][bj][m][n] = __builtin_bit_cast(f32x4, __builtin_amdgcn_mfma_i32_16x16x64_i8(__builtin_bit_cast(v4i_t, Bt[n][k]), __builtin_bit_cast(v4i_t, At[m][k]), __builtin_bit_cast(v4i_t, acc[ai][bj][m][n]), 0, 0, 0)); } \
        else { _Pragma("unroll") for (int m = 0; m < 4; ++m) _Pragma("unroll") for (int n = 0; n < 2; ++n) _Pragma("unroll") for (int k = 0; k < 2; ++k) \
            acc[ai][bj][m][n] = SWAP ? __builtin_amdgcn_mfma_f32_16x16x32_bf16(At[m][k], Bt[n][k], acc[ai][bj][m][n], 0, 0, 0) \
                                     : __builtin_amdgcn_mfma_f32_16x16x32_bf16(Bt[n][k], At[m][k], acc[ai][bj][m][n], 0, 0, 0); } \
        __builtin_amdgcn_s_setprio(0); } while (0)
#define PG8_WAIT_V(n) asm volatile("s_waitcnt vmcnt(" #n ")" ::: "memory")
#define PG8_WAIT_L(n) asm volatile("s_waitcnt lgkmcnt(" #n ")" ::: "memory")
#define PG8_BAR __builtin_amdgcn_s_barrier()
#define PG8_SCHED __builtin_amdgcn_sched_barrier(0)
    Unit cur, nxt; int ui = 0;
    if (!S.next(0, cur)) return;
    int f8scale = 0x7F7F7F7F; asm volatile("" : "+v"(f8scale));
    f32x4 acc[2][2][4][2];
#pragma unroll
    for (int a = 0; a < 2; ++a)
#pragma unroll
        for (int b = 0; b < 2; ++b)
#pragma unroll
            for (int m = 0; m < 4; ++m)
#pragma unroll
                for (int n = 0; n < 2; ++n) acc[a][b][m][n] = (f32x4){0.f, 0.f, 0.f, 0.f};
    bf16x8 At[4][2], B0[2][2], B1[2][2];
    const char* cA = (const char*)g.A + (size_t)cur.pm * tstepA; const char* cB = (const char*)g.Bt + (size_t)cur.pn * tstepB;
    if constexpr (SP2) {
        PG8_STAGE(PG8_SB(0, 0), cB, voffB); PG8_STAGE(PG8_SB(0, 1), cB + hstepB, voffB); PG8_STAGE(PG8_SA(0, 0), cA, voffA); PG8_STAGE(PG8_SA(0, 1), cA + hstepA, voffA);
        if (wr == 1) PG8_BAR;
        PG8_WAIT_V(2); PG8_BAR;
        PG8_STAGE(PG8_SB(1, 0), cB + kstep, voffB); PG8_STAGE(PG8_SA(1, 0), cA + kstep, voffA); PG8_STAGE(PG8_SB(1, 1), cB + hstepB + kstep, voffB);
        PG8_WAIT_V(6); PG8_BAR;
    } else {
        PG8_STAGE(PG8_SB(0, 0), cB, voffB); PG8_STAGE(PG8_SA(0, 0), cA, voffA); PG8_STAGE(PG8_SB(0, 1), cB + hstepB, voffB); PG8_STAGE(PG8_SA(0, 1), cA + hstepA, voffA);
        if (wr == 1) PG8_BAR;
        PG8_WAIT_V(4); PG8_BAR;
        PG8_STAGE(PG8_SB(1, 0), cB + kstep, voffB); PG8_STAGE(PG8_SA(1, 0), cA + kstep, voffA); PG8_STAGE(PG8_SB(1, 1), cB + hstepB + kstep, voffB);
        PG8_WAIT_V(6); PG8_BAR;
    }
    for (;;) {
        const bool has_next = S.next(ui + 1, nxt);
        if constexpr (Epi::STAGED) E.pre(cur, ui, wid, lane);
        const char* nA = has_next ? (const char*)g.A + (size_t)nxt.pm * tstepA : cA; const char* nB = has_next ? (const char*)g.Bt + (size_t)nxt.pn * tstepB : cB;
        for (int t = 0; t < nt; t += 2) {
            const bool last = (t == nt - 2);
            const char* a1 = cA + (size_t)(t + 1) * kstep;
            const char* a2 = last ? nA : cA + (size_t)(t + 2) * kstep; const char* b2 = last ? nB : cB + (size_t)(t + 2) * kstep;
            const char* a3 = a2 + kstep; const char* b3 = b2 + kstep;
            if constexpr (SP2) {
            PG8_LDB(B0, 0, 0); PG8_LDB(B1, 0, 1); PG8_SCHED; PG8_LDA(At, 0, 0); PG8_STAGE(PG8_SA(1, 1), a1 + hstepA, voffA);
            PG8_WAIT_V(8); PG8_WAIT_L(0); PG8_BAR; PG8_MMA(0, 0, At, B0); PG8_MMA(0, 1, At, B1); PG8_BAR; PG8_SCHED;
            PG8_LDA(At, 0, 1); PG8_STAGE(PG8_SB(0, 0), b2, voffB); PG8_STAGE(PG8_SB(0, 1), b2 + hstepB, voffB); PG8_STAGE(PG8_SA(0, 0), a2, voffA);
            PG8_WAIT_V(8); PG8_WAIT_L(0); PG8_BAR; PG8_MMA(1, 0, At, B0); PG8_MMA(1, 1, At, B1); PG8_BAR; PG8_SCHED;
            PG8_LDB(B0, 1, 0); PG8_LDB(B1, 1, 1); PG8_SCHED; PG8_LDA(At, 1, 0); PG8_STAGE(PG8_SA(0, 1), a2 + hstepA, voffA);
            PG8_WAIT_V(8); PG8_WAIT_L(0); PG8_BAR; PG8_MMA(0, 0, At, B0); PG8_MMA(0, 1, At, B1); PG8_BAR; PG8_SCHED;
            PG8_LDA(At, 1, 1); PG8_STAGE(PG8_SB(1, 0), b3, voffB); PG8_STAGE(PG8_SB(1, 1), b3 + hstepB, voffB); PG8_STAGE(PG8_SA(1, 0), a3, voffA);
            PG8_WAIT_V(8); PG8_WAIT_L(0); PG8_BAR; PG8_MMA(1, 0, At, B0); PG8_MMA(1, 1, At, B1); PG8_BAR; PG8_SCHED;
            } else {
            PG8_LDB(B0, 0, 0); PG8_SCHED; PG8_LDA(At, 0, 0); PG8_STAGE(PG8_SA(1, 1), a1 + hstepA, voffA);
            PG8_WAIT_L(8); PG8_BAR; PG8_WAIT_L(0); PG8_MMA(0, 0, At, B0); PG8_BAR; PG8_SCHED;
            PG8_LDB(B1, 0, 1); PG8_STAGE(PG8_SB(0, 0), b2, voffB);
            PG8_BAR; PG8_WAIT_L(0); PG8_MMA(0, 1, At, B1); PG8_BAR;
            PG8_LDA(At, 0, 1); PG8_STAGE(PG8_SA(0, 0), a2, voffA);
            PG8_BAR; PG8_WAIT_L(0); PG8_MMA(1, 0, At, B0); PG8_BAR; PG8_SCHED;
            PG8_STAGE(PG8_SB(0, 1), b2 + hstepB, voffB);
            PG8_WAIT_V(6); PG8_BAR; PG8_MMA(1, 1, At, B1); PG8_BAR;
            PG8_LDB(B0, 1, 0); PG8_SCHED; PG8_LDA(At, 1, 0); PG8_STAGE(PG8_SA(0, 1), a2 + hstepA, voffA);
            PG8_WAIT_L(8); PG8_BAR; PG8_WAIT_L(0); PG8_MMA(0, 0, At, B0); PG8_BAR; PG8_SCHED;
            PG8_LDB(B1, 1, 1); PG8_STAGE(PG8_SB(1, 0), b3, voffB);
            PG8_BAR; PG8_WAIT_L(0); PG8_MMA(0, 1, At, B1); PG8_BAR;
            PG8_LDA(At, 1, 1); PG8_STAGE(PG8_SA(1, 0), a3, voffA);
            PG8_BAR; PG8_WAIT_L(0); PG8_MMA(1, 0, At, B0); PG8_BAR; PG8_SCHED;
            PG8_STAGE(PG8_SB(1, 1), b3 + hstepB, voffB);
            PG8_WAIT_V(6); PG8_BAR; PG8_MMA(1, 1, At, B1); PG8_BAR;
            }
        }
        if constexpr (F8) asm volatile("s_nop 15\n\ts_nop 15" ::: "memory");
        if constexpr (ALIGN_EPI) { if (wr == 0) PG8_BAR; }
        { int tz = my_tid(); asm volatile("" : "+v"(tz));
          const int lz = tz & 63; if constexpr (Epi::STAGED) E.run(acc, cur, wr, wc, lz & 15, lz >> 4, tz, ui); else E(acc, cur, wr, wc, lz & 15, lz >> 4); }
        if (!has_next) break;
#pragma unroll
        for (int a = 0; a < 2; ++a)
#pragma unroll
            for (int b = 0; b < 2; ++b)
#pragma unroll
                for (int m = 0; m < 4; ++m)
#pragma unroll
                    for (int n = 0; n < 2; ++n) acc[a][b][m][n] = (f32x4){0.f, 0.f, 0.f, 0.f};
        cur = nxt; cA = nA; cB = nB; ++ui;
        if constexpr (ALIGN_EPI) { if (wr == 1) PG8_BAR; }
    }
    PG8_WAIT_V(0);
    if constexpr (!ALIGN_EPI) { if (wr == 0) PG8_BAR; }
    PG8_BAR;
#undef PG8_SA
#undef PG8_SB
#undef PG8_STAGE
#undef PG8_LDA
#undef PG8_LDB
#undef PG8_MMA
#undef PG8_WAIT_V
#undef PG8_WAIT_L
#undef PG8_BAR
#undef PG8_SCHED
}
}

#define GAS __attribute__((address_space(1)))
#define LAS __attribute__((address_space(3)))
typedef unsigned v4u __attribute__((ext_vector_type(4)));
typedef unsigned v2u __attribute__((ext_vector_type(2)));
typedef float f32x4 __attribute__((ext_vector_type(4)));
typedef short bf16x8 __attribute__((ext_vector_type(8)));
#define LDS_WAIT() asm volatile("s_waitcnt lgkmcnt(0)" ::: "memory")
#define VM_WAIT() asm volatile("s_waitcnt vmcnt(0)" ::: "memory")
__device__ __forceinline__ unsigned pk2(float lo, float hi) { return pg8::cvt_pk_bf16(lo, hi); }

constexpr int NWAVES = 8, NTHR = 512;
constexpr int CONV_P3_PER_WAVE = 17, CONV_P2_PER_WAVE = 6, CONV_P4_PER_WAVE = 4, CONV_P5_PER_WAVE = 3;
constexpr int CONV_W1B = 16 * 2048, CONV_W2 = 32 * 2048, CONV_END = 32 * 2048 + 32 * 1024;
constexpr int CONV_P1 = 50 * 8 * 7;
constexpr int RING_BYTES = 131072, MISC_OFF = 153600, LDS_BYTES = 155648;
constexpr int CW_BAR = 4096;

#define XB_TMO      128
#define XB_XCNT(j)  (256  + 64 * (j))
#define XB_XSUB(j)  (1280 + 64 * (j))
#define XB_XGEN(j)  (2304 + 64 * (j))
#define XB_TOP      3328
#define XB_TOPGEN   3392
#define XCD_BAR_WORDS 3456
#define XB_SPIN_CAP (1u << 18)
__device__ __forceinline__ unsigned xb_ld(unsigned* p)              { return __hip_atomic_load(p, __ATOMIC_RELAXED, __HIP_MEMORY_SCOPE_AGENT); }
__device__ __forceinline__ unsigned xb_add(unsigned* p, unsigned v) { return __hip_atomic_fetch_add(p, v, __ATOMIC_RELAXED, __HIP_MEMORY_SCOPE_AGENT); }
__device__ __forceinline__ unsigned xb_xcc_id() { return (unsigned)__builtin_amdgcn_s_getreg((3 << 11) | 20) & 0xFu; }
#define XB_SPIN(cond, bar) do { unsigned _sp = 0; while (cond) { __builtin_amdgcn_s_sleep(1); \
    if ((++_sp & 255u) == 0u) { if (xb_ld(&(bar)[XB_TMO])) break; if (_sp > XB_SPIN_CAP) { atomicAdd(&(bar)[XB_TMO], 1u); break; } } } } while (0)
struct XcdBarrier { unsigned* bar; unsigned x; volatile LAS unsigned* st; };
__device__ __forceinline__ XcdBarrier xcd_barrier_post(unsigned* bar, volatile LAS unsigned* st) {
    XcdBarrier b; b.bar = bar; b.x = xb_xcc_id(); b.st = st;
    if (my_tid() == 0) (void)xb_add(&bar[XB_XCNT(b.x)], 1u);
    return b;
}
__device__ __forceinline__ void xcd_barrier_complete(unsigned* bar, unsigned x, unsigned& nloc, unsigned& nx) {
    const unsigned G = gridDim.x * gridDim.y * gridDim.z;
    unsigned sum, cnt, mine, sp = 0u;
    for (;;) {
        sum = 0u; cnt = 0u; mine = 0u;
#pragma unroll
        for (unsigned j = 0; j < 16; ++j) { const unsigned c = xb_ld(&bar[XB_XCNT(j)]); sum += c; cnt += (c > 0u) ? 1u : 0u; mine = (j == x) ? c : mine; }
        if (sum == G) break;
        __builtin_amdgcn_s_sleep(1);
        if ((++sp & 255u) == 0u) { if (xb_ld(&bar[XB_TMO])) break; if (sp > XB_SPIN_CAP) { atomicAdd(&bar[XB_TMO], 1u); break; } }
    }
    nloc = mine > 0u ? mine : 1u; nx = cnt > 0u ? cnt : 1u;
}
__device__ __forceinline__ void xcd_barrier(const XcdBarrier& b) {
    asm volatile("s_waitcnt vmcnt(0)" ::: "memory");
    __syncthreads();
    if (my_tid() == 0) {
        unsigned* bar = b.bar;
        __builtin_amdgcn_s_waitcnt(0);
        unsigned nloc = b.st[0], nx = b.st[1];
        if (nloc == 0u) { xcd_barrier_complete(bar, b.x, nloc, nx); b.st[0] = nloc; b.st[1] = nx; }
        const unsigned old = xb_add(&bar[XB_XSUB(b.x)], 1u);
        const unsigned gen = old / nloc;
        if (old + 1u == (gen + 1u) * nloc) {
            __builtin_amdgcn_fence(__ATOMIC_RELEASE, "agent");
            asm volatile("s_waitcnt vmcnt(0)" ::: "memory");
            const unsigned og = xb_add(&bar[XB_TOP], 1u);
            const unsigned tg = og / nx;
            if (og + 1u == (tg + 1u) * nx) xb_add(&bar[XB_TOPGEN], 1u);
            else XB_SPIN(xb_ld(&bar[XB_TOPGEN]) == tg, bar);
            __builtin_amdgcn_fence(__ATOMIC_ACQUIRE, "agent");
            xb_add(&bar[XB_XGEN(b.x)], 1u);
            asm volatile("s_waitcnt vmcnt(0)" ::: "memory");
        } else {
            XB_SPIN(xb_ld(&bar[XB_XGEN(b.x)]) == gen, bar);
            __builtin_amdgcn_fence(__ATOMIC_ACQUIRE, "agent");
            asm volatile("s_waitcnt vmcnt(0)" ::: "memory");
        }
    }
    __syncthreads();
}

struct Args { const float* in[25]; float* out; unsigned char* ws; int ph_lo, ph_hi; };

template <class SrcCol>
__device__ __forceinline__ void transpose_item(const float* W, int ldw, int K, bf16* WT, int n0, int k0, const SrcCol& sc, const float* kscale, LAS float* scr, int lane) {
    const int csrc = sc(n0 + (lane & 31));
#pragma unroll 8
    for (int i = 0; i < 32; ++i) { const int kk = 2 * i + (lane >> 5);
        float v = 0.f; if (csrc >= 0) { v = W[(size_t)(k0 + kk) * ldw + csrc]; if (kscale) v *= kscale[k0 + kk]; }
        scr[kk * 33 + (lane & 31)] = v; }
    LDS_WAIT(); asm volatile("" ::: "memory");
    const int c = lane & 7;
#pragma unroll
    for (int j = 0; j < 4; ++j) { const int n = (lane >> 3) + 8 * j; const LAS float* s = scr + (8 * c) * 33 + n;
        v4u o; o.x = pk2(s[0 * 33], s[1 * 33]); o.y = pk2(s[2 * 33], s[3 * 33]); o.z = pk2(s[4 * 33], s[5 * 33]); o.w = pk2(s[6 * 33], s[7 * 33]);
        *(v4u*)(WT + (size_t)(n0 + n) * K + k0 + 8 * c) = o; }
    LDS_WAIT(); asm volatile("" ::: "memory");
}

typedef short v4i16_t __attribute__((ext_vector_type(4)));
__device__ __forceinline__ int tsw(int kk) { return ((kk >> 1) & 1) | (((kk >> 4) & 1) << 1); }
typedef short s16x2_t __attribute__((ext_vector_type(2)));
__device__ __forceinline__ unsigned f8x4(unsigned lo2, unsigned hi2) {
    s16x2_t r = {0, 0};
    r = __builtin_amdgcn_cvt_scalef32_pk_fp8_bf16(r, __builtin_bit_cast(bf16x2v, lo2), 1.0f / F8_SW, false);
    r = __builtin_amdgcn_cvt_scalef32_pk_fp8_bf16(r, __builtin_bit_cast(bf16x2v, hi2), 1.0f / F8_SW, true);
    return __builtin_bit_cast(unsigned, r);
}
struct TI64 { const float* src; unsigned char* dst; int ldw, K; };
__device__ __forceinline__ TI64 ti64_desc(int it, const float* w1, const float* w2, unsigned char* wt1, unsigned char* wt2, int lane) {
    constexpr int I1 = (D / 128) * (4096 / 32), I2 = (DFF / 128) * (D / 32);
    const int r8 = lane >> 3, c8 = lane & 7; TI64 t;
    if (it < NE * I1) { const int e = it / I1, r = it - e * I1, nb = r & 127, kb = r >> 7; const int pn = nb >> 3, j0 = (nb & 7) * 32;
        const int src0 = (j0 < 128) ? (128 * pn + j0) : (2048 + 128 * pn + j0 - 128);
        t.ldw = 4096; t.K = D; t.src = w1 + (size_t)e * D * 4096 + (size_t)(128 * kb + r8) * 4096 + src0 + 4 * c8; t.dst = wt1 + (size_t)e * 4096 * D + (size_t)(32 * nb) * D + 128 * kb; }
    else { const int q = it - NE * I1, e = q / I2, r = q - e * I2, nb = r & 63, kb = r >> 6;
        t.ldw = D; t.K = DFF; t.src = w2 + (size_t)e * DFF * D + (size_t)(128 * kb + r8) * D + 32 * nb + 4 * c8; t.dst = wt2 + (size_t)e * D * DFF + (size_t)(32 * nb) * DFF + 128 * kb; }
    return t;
}
__device__ __forceinline__ void ti64_load(const TI64& t, f32x4 (&v)[16]) {
#pragma unroll
    for (int i = 0; i < 16; ++i) v[i] = __builtin_nontemporal_load((const f32x4*)(t.src + (size_t)(8 * i) * t.ldw));
}
__device__ __forceinline__ void ti64_store(const TI64& t, const f32x4 (&v)[16], LAS unsigned char* tile, int lane) {
    const int r8 = lane >> 3, c8 = lane & 7;
#pragma unroll
    for (int i = 0; i < 16; ++i) { const int kk = 8 * i + r8;
        v2u o; o.x = pg8::cvt_pk_bf16(v[i][0], v[i][1]); o.y = pg8::cvt_pk_bf16(v[i][2], v[i][3]);
        *(LAS v2u*)(tile + kk * 64 + ((((c8 >> 2) ^ (kk >> 4)) & 1) << 5) + ((c8 & 3) << 3)) = o; }
    asm volatile("" ::: "memory");
    const int G = lane >> 4, i16 = lane & 15, q = i16 >> 2, p = i16 & 3; const bool hi = i16 >= 8;
#pragma unroll
    for (int nbu = 0; nbu < 2; ++nbu) { unsigned oe[4], oo[4];
#pragma unroll
        for (int h = 0; h < 2; ++h) { const int c = 4 * h + G;
#pragma unroll
            for (int j = 0; j < 4; ++j) { const int kk = 16 * c + 4 * j + q;
                const v4i16_t tr = __builtin_amdgcn_ds_read_tr16_b64_v4i16((LAS v4i16_t*)(tile + kk * 64 + (((nbu ^ c) & 1) << 5) + (p << 3)));
                const v2u tu = __builtin_bit_cast(v2u, tr); (h ? oo : oe)[j] = f8x4(tu.x, tu.y); } }
        v4u sa, sb;
#pragma unroll
        for (int j = 0; j < 4; ++j) { const unsigned send = hi ? oe[j] : oo[j]; const unsigned recv = (unsigned)__builtin_amdgcn_mov_dpp((int)send, 0x128, 0xf, 0xf, true);
            const unsigned a_ = hi ? recv : oe[j], b_ = hi ? oo[j] : recv; sa[j] = a_; sb[j] = b_; }
        unsigned char* rowp = t.dst + (size_t)(16 * nbu + (i16 & 7)) * t.K + 16 * (G + (hi ? 4 : 0));
        __builtin_nontemporal_store(sa, (v4u*)rowp);
        __builtin_nontemporal_store(sb, (v4u*)(rowp + (size_t)8 * t.K)); }
    asm volatile("" ::: "memory");
}

__device__ __forceinline__ void tb16_item(const float* W, int ldw, int K, bf16* WT, int n0, int src0, int k0, const float* kscale, LAS unsigned char* tile, int lane) {
    const int r8 = lane >> 3, c8 = lane & 7;
    f32x4 v[16];
    const float* src = W + (size_t)(k0 + r8) * ldw + src0 + 4 * c8;
#pragma unroll
    for (int i = 0; i < 16; ++i) v[i] = __builtin_nontemporal_load((const f32x4*)(src + (size_t)(8 * i) * ldw));
#pragma unroll
    for (int i = 0; i < 16; ++i) { const int kk = 8 * i + r8; const float sc = kscale ? kscale[k0 + kk] : 1.0f;
        v2u o; o.x = pg8::cvt_pk_bf16(v[i][0] * sc, v[i][1] * sc); o.y = pg8::cvt_pk_bf16(v[i][2] * sc, v[i][3] * sc);
        *(LAS v2u*)(tile + kk * 64 + ((((c8 >> 2) ^ (kk >> 4)) & 1) << 5) + ((c8 & 3) << 3)) = o; }
    asm volatile("" ::: "memory");
    const int G = lane >> 4, i16 = lane & 15, q = i16 >> 2, p = i16 & 3;
#pragma unroll
    for (int tt = 0; tt < 4; ++tt) { const int nbu = tt >> 1, c = 4 * (tt & 1) + G; v4u o0, o1; unsigned ov[8];
#pragma unroll
        for (int j = 0; j < 4; ++j) { const int kk = 16 * c + 4 * j + q;
            const v4i16_t tr = __builtin_amdgcn_ds_read_tr16_b64_v4i16((LAS v4i16_t*)(tile + kk * 64 + (((nbu ^ c) & 1) << 5) + (p << 3)));
            const v2u tu = __builtin_bit_cast(v2u, tr); ov[2 * j] = tu.x; ov[2 * j + 1] = tu.y; }
        o0.x = ov[0]; o0.y = ov[1]; o0.z = ov[2]; o0.w = ov[3]; o1.x = ov[4]; o1.y = ov[5]; o1.z = ov[6]; o1.w = ov[7];
        bf16* dst = WT + (size_t)(n0 + 16 * nbu + i16) * K + k0 + 16 * c;
        *(v4u*)dst = o0; *(v4u*)(dst + 8) = o1; }
    asm volatile("" ::: "memory");
}
__device__ __forceinline__ void conv_items(int first, int end, int stride, const float* w1, const float* w2, unsigned char* wt1, unsigned char* wt2, LAS unsigned char* tile, int lane) {
    if (first >= end) return;
    const int n = (end - first + stride - 1) / stride;
    f32x4 va[16], vb[16]; TI64 ta, tb;
    ta = ti64_desc(first, w1, w2, wt1, wt2, lane); ti64_load(ta, va);
    int k = 1;
    while (k + 1 < n) {
        tb = ti64_desc(first + k * stride, w1, w2, wt1, wt2, lane); ti64_load(tb, vb);
        ti64_store(ta, va, tile, lane);
        ta = ti64_desc(first + (k + 1) * stride, w1, w2, wt1, wt2, lane); ti64_load(ta, va);
        ti64_store(tb, vb, tile, lane);
        k += 2;
    }
    if (k < n) { tb = ti64_desc(first + k * stride, w1, w2, wt1, wt2, lane); ti64_load(tb, vb); ti64_store(ta, va, tile, lane); ti64_store(tb, vb, tile, lane); }
    else ti64_store(ta, va, tile, lane);
}
__device__ __forceinline__ unsigned i8x4(unsigned lo2, unsigned hi2) {
    return pack_i8x4(__uint_as_float(lo2 << 16), __uint_as_float(lo2 & 0xffff0000u), __uint_as_float(hi2 << 16), __uint_as_float(hi2 & 0xffff0000u));
}
__device__ __forceinline__ void ti64_store_i8(const TI64& t, const f32x4 (&v)[16], LAS unsigned char* tile, int lane) {
    const int r8 = lane >> 3, c8 = lane & 7;
#pragma unroll
    for (int i = 0; i < 16; ++i) { const int kk = 8 * i + r8;
        v2u o; o.x = pg8::cvt_pk_bf16(v[i][0], v[i][1]); o.y = pg8::cvt_pk_bf16(v[i][2], v[i][3]);
        *(LAS v2u*)(tile + kk * 64 + ((((c8 >> 2) ^ (kk >> 4)) & 1) << 5) + ((c8 & 3) << 3)) = o; }
    asm volatile("" ::: "memory");
    const int G = lane >> 4, i16 = lane & 15, q = i16 >> 2, p = i16 & 3;
#pragma unroll
    for (int tt = 0; tt < 4; ++tt) { const int nbu = tt >> 1, c = 4 * (tt & 1) + G; v4u o; unsigned ov[4];
#pragma unroll
        for (int j = 0; j < 4; ++j) { const int kk = 16 * c + 4 * j + q;
            const v4i16_t tr = __builtin_amdgcn_ds_read_tr16_b64_v4i16((LAS v4i16_t*)(tile + kk * 64 + (((nbu ^ c) & 1) << 5) + (p << 3)));
            const v2u tu = __builtin_bit_cast(v2u, tr); ov[j] = i8x4(tu.x, tu.y); }
        o.x = ov[0]; o.y = ov[1]; o.z = ov[2]; o.w = ov[3];
        *(v4u*)(t.dst + (size_t)(16 * nbu + i16) * t.K + 16 * c) = o; }
    asm volatile("" ::: "memory");
}
__device__ __forceinline__ void wtin_block(LAS unsigned char* lds, int nb, const float* W, unsigned char* wt8, float* csc, int tid) {
    const int lane = tid & 63, wave = tid >> 6, r8 = lane >> 3, c8 = lane & 7;
    int sc[4];
#pragma unroll
    for (int q = 0; q < 4; ++q) sc[q] = proj_src_col(32 * nb + 4 * c8 + q);
    const bool contig = nb < 104;
    f32x4 v[2][16];
#pragma unroll
    for (int it = 0; it < 2; ++it)
#pragma unroll
        for (int i = 0; i < 16; ++i) { const float* rowp = W + (size_t)(128 * (2 * wave + it) + 8 * i + r8) * NPROJ;
            if (contig) v[it][i] = __builtin_nontemporal_load((const f32x4*)(rowp + sc[0]));
            else {
#pragma unroll
                for (int q = 0; q < 4; ++q) v[it][i][q] = sc[q] >= 0 ? rowp[sc[q]] : 0.f; } }
    float am[4] = {0.f, 0.f, 0.f, 0.f};
#pragma unroll
    for (int it = 0; it < 2; ++it)
#pragma unroll
        for (int i = 0; i < 16; ++i)
#pragma unroll
            for (int q = 0; q < 4; ++q) am[q] = fmaxf(am[q], fabsf(v[it][i][q]));
    LAS float* cm = (LAS float*)(lds + 131072);
#pragma unroll
    for (int q = 0; q < 4; ++q) { am[q] = fmaxf(am[q], __shfl_xor(am[q], 8)); am[q] = fmaxf(am[q], __shfl_xor(am[q], 16)); am[q] = fmaxf(am[q], __shfl_xor(am[q], 32)); }
    if (r8 == 0) {
#pragma unroll
        for (int q = 0; q < 4; ++q) cm[wave * 32 + 4 * c8 + q] = am[q]; }
    __syncthreads();
    float inv[4];
#pragma unroll
    for (int q = 0; q < 4; ++q) { float m = 0.f;
#pragma unroll
        for (int w = 0; w < 8; ++w) m = fmaxf(m, cm[w * 32 + 4 * c8 + q]);
        inv[q] = m > 0.f ? 127.0f / m : 0.f; if (wave == 0 && r8 == 0) csc[32 * nb + 4 * c8 + q] = m * (1.0f / 127.0f); }
#pragma unroll
    for (int it = 0; it < 2; ++it) {
#pragma unroll
        for (int i = 0; i < 16; ++i)
#pragma unroll
            for (int q = 0; q < 4; ++q) v[it][i][q] = rintf(v[it][i][q] * inv[q]);
        TI64 t; t.src = nullptr; t.ldw = 0; t.K = D; t.dst = wt8 + (size_t)(32 * nb) * D + 128 * (2 * wave + it);
        ti64_store_i8(t, v[it], lds + wave * 16384, lane); }
    __syncthreads();
}
struct SC_in  { __device__ int operator()(int n) const { return proj_src_col(n); } };
struct SC_uq  { __device__ int operator()(int n) const { const int h = n / DQK, d = n - h * DQK; if (d < 128) return n; const int i = d - 128; return h * DQK + 128 + (i >> 1) + 32 * (i & 1); } };
struct SC_id  { __device__ int operator()(int n) const { return n; } };
struct SC_w1  { __device__ int operator()(int n) const { const int pn = n >> 8, j = n & 255; return (j < 128) ? (128 * pn + j) : (2048 + 128 * pn + j - 128); } };

struct EpiProj { static constexpr bool PERM = true, STAGED = false;
    bf16* proj; float* ssqp; const float* rsc; const float* csc;
    __device__ __forceinline__ void operator()(const f32x4 (&acc)[2][2][4][2], const pg8::Unit& u, int wr, int wc, int fr, int fq) const {
        const int row0 = u.pm * 256 + wr * 64 + fr, col0 = u.pn * 256 + wc * 32 + 8 * fq;
#pragma unroll
        for (int ai = 0; ai < 2; ++ai)
#pragma unroll
            for (int m = 0; m < 4; ++m) { const int r = row0 + ai * 128 + m * 16; float ss = 0.f; const float rs = rsc[r];
#pragma unroll
                for (int bj = 0; bj < 2; ++bj) { const f32x4 c0 = *(const f32x4*)(csc + col0 + bj * 128), c1 = *(const f32x4*)(csc + col0 + bj * 128 + 4);
                    const f32x4 v0 = __builtin_convertvector(__builtin_bit_cast(pg8::v4i_t, acc[ai][bj][m][0]), f32x4) * c0 * rs, v1 = __builtin_convertvector(__builtin_bit_cast(pg8::v4i_t, acc[ai][bj][m][1]), f32x4) * c1 * rs;
                    v4u o; o.x = pk2(v0[0], v0[1]); o.y = pk2(v0[2], v0[3]); o.z = pk2(v1[0], v1[1]); o.w = pk2(v1[2], v1[3]);
                    *(v4u*)(proj + (size_t)r * NPROJP + col0 + bj * 128) = o;
                    ss += v0[0] * v0[0] + v0[1] * v0[1] + v0[2] * v0[2] + v0[3] * v0[3] + v1[0] * v1[0] + v1[1] * v1[1] + v1[2] * v1[2] + v1[3] * v1[3]; }
                if (u.pn < 5) { ss += __shfl_xor(ss, 16); ss += __shfl_xor(ss, 32); if (fq == 0) ssqp[(size_t)r * 20 + 4 * u.pn + wc] = ss; } }
    }
};


__device__ __forceinline__ float ssq_q_of(const float* ssqp, int r) { const f32x4* p = (const f32x4*)(ssqp + (size_t)r * 20); const f32x4 a = p[0], b = p[1], c = p[2];
    return ((a[0] + a[1]) + (a[2] + a[3])) + ((b[0] + b[1]) + (b[2] + b[3])) + ((c[0] + c[1]) + (c[2] + c[3])); }
__device__ __forceinline__ float ssq_kv_of(const float* ssqp, int r) { const f32x4* p = (const f32x4*)(ssqp + (size_t)r * 20 + 12); const f32x4 a = p[0], b = p[1];
    return ((a[0] + a[1]) + (a[2] + a[3])) + ((b[0] + b[1]) + (b[2] + b[3])); }
struct EpiQ { static constexpr bool PERM = true, STAGED = false;
    bf16* Q; const float* ssqp; const float* rope;
    __device__ __forceinline__ void operator()(const f32x4 (&acc)[2][2][4][2], const pg8::Unit& u, int wr, int wc, int fr, int fq) const {
        const int row0 = u.pm * 256 + wr * 64 + fr;
#pragma unroll
        for (int ai = 0; ai < 2; ++ai)
#pragma unroll
            for (int m = 0; m < 4; ++m) { const int r = row0 + ai * 128 + m * 16; const int b = r >> 11, s = r & 2047, pos = s + NMETA;
                const float rs = (1.0f / sqrtf(ssq_q_of(ssqp, r) * (1.f / QL) + RMS_EPS)) * QSCALE;
#pragma unroll
                for (int bj = 0; bj < 2; ++bj) { const int c0 = u.pn * 256 + bj * 128 + wc * 32 + 8 * fq; const int h = c0 / DQK, d0 = c0 - h * DQK;
                    f32x4 v0 = acc[ai][bj][m][0] * rs, v1 = acc[ai][bj][m][1] * rs;
                    if (d0 >= 128) { const f32x4* rp = (const f32x4*)(rope + (size_t)(pos * 32 + ((d0 - 128) >> 1)) * 2); const f32x4 r0 = rp[0], r1 = rp[1];
                        f32x4 w0, w1;
                        w0[0] = v0[0] * r0[0] - v0[1] * r0[1]; w0[1] = v0[1] * r0[0] + v0[0] * r0[1];
                        w0[2] = v0[2] * r0[2] - v0[3] * r0[3]; w0[3] = v0[3] * r0[2] + v0[2] * r0[3];
                        w1[0] = v1[0] * r1[0] - v1[1] * r1[1]; w1[1] = v1[1] * r1[0] + v1[0] * r1[1];
                        w1[2] = v1[2] * r1[2] - v1[3] * r1[3]; w1[3] = v1[3] * r1[2] + v1[2] * r1[3];
                        v0 = w0; v1 = w1; }
                    v4u o; o.x = pk2(v0[0], v0[1]); o.y = pk2(v0[2], v0[3]); o.z = pk2(v1[0], v1[1]); o.w = pk2(v1[2], v1[3]);
                    *(v4u*)(Q + (((size_t)b * NH + h) * S + s) * DQK + d0) = o; } }
    }
};
struct EpiKV { static constexpr bool PERM = true, STAGED = false;
    bf16* Kc; bf16* Vt; const float* ssqp; const bf16* proj; const float* rope;
    __device__ __forceinline__ void operator()(const f32x4 (&acc)[2][2][4][2], const pg8::Unit& u, int wr, int wc, int fr, int fq) const {
        const int row0 = u.pm * 256 + wr * 64 + fr;
#pragma unroll
        for (int ai = 0; ai < 2; ++ai)
#pragma unroll
            for (int m = 0; m < 4; ++m) { const int r = row0 + ai * 128 + m * 16;
                if (r < T + NMETA) {
                    const float rs = 1.0f / sqrtf(ssq_kv_of(ssqp, r) * (1.f / KVL) + RMS_EPS);
                    int b0, b1, key; if (r < T) { b0 = r >> 11; b1 = b0 + 1; key = NMETA + (r & 2047); } else { b0 = 0; b1 = NB; key = r - T; }
#pragma unroll
                    for (int bj = 0; bj < 2; ++bj) { const int c0 = u.pn * 256 + bj * 128 + wc * 32 + 8 * fq;
                        const f32x4 v0 = acc[ai][bj][m][0] * rs, v1 = acc[ai][bj][m][1] * rs;
                        const int h = c0 >> 7, d0 = c0 & 127;
                        v4u o; o.x = pk2(v0[0], v0[1]); o.y = pk2(v0[2], v0[3]); o.z = pk2(v1[0], v1[1]); o.w = pk2(v1[2], v1[3]);
                        for (int b = b0; b < b1; ++b) *(v4u*)(Kc + (((size_t)b * NH + h) * KPAD + key) * DQK + d0) = o; }
                }
            }
        if (u.pn < 4) {
#pragma unroll
            for (int ai = 0; ai < 2; ++ai) { const int r = row0 + ai * 128 + wc * 16;
                if (r < T + NMETA) {
                    int b0, b1, key; if (r < T) { b0 = r >> 11; b1 = b0 + 1; key = NMETA + (r & 2047); } else { b0 = 0; b1 = NB; key = r - T; }
                    const int h = 2 * u.pn + (fq & 1), half = fq >> 1;
                    const v4u* src = (const v4u*)(proj + (size_t)r * NPROJP + PC_KPE + 32 * half);
                    const f32x4* rp = (const f32x4*)(rope + (size_t)(key * 32 + 16 * half) * 2);
                    v4u o[4];
#pragma unroll
                    for (int q = 0; q < 4; ++q) { const v4u x = src[q]; const f32x4 ra = rp[2 * q], rb = rp[2 * q + 1];
                        const unsigned xs[4] = {x.x, x.y, x.z, x.w}; const float cs[8] = {ra[0], ra[1], ra[2], ra[3], rb[0], rb[1], rb[2], rb[3]}; unsigned ov[4];
#pragma unroll
                        for (int p = 0; p < 4; ++p) { const float x1 = __uint_as_float(xs[p] << 16), x2 = __uint_as_float(xs[p] & 0xffff0000u); const float c = cs[2 * p], sn = cs[2 * p + 1];
                            ov[p] = pk2(x1 * c - x2 * sn, x2 * c + x1 * sn); }
                        o[q].x = ov[0]; o[q].y = ov[1]; o[q].z = ov[2]; o[q].w = ov[3]; }
                    for (int b = b0; b < b1; ++b) { v4u* dst = (v4u*)(Kc + (((size_t)b * NH + h) * KPAD + key) * DQK + 128 + 32 * half);
#pragma unroll
                        for (int q = 0; q < 4; ++q) dst[q] = o[q]; }
                }
            }
        }
    }
};

struct EpiVt { static constexpr bool PERM = true, STAGED = false;
    bf16* Vt; const float* ssqp;
    __device__ __forceinline__ void operator()(const f32x4 (&acc)[2][2][4][2], const pg8::Unit& u, int wr, int wc, int fr, int fq) const {
#pragma unroll
        for (int ai = 0; ai < 2; ++ai)
#pragma unroll
            for (int m = 0; m < 4; ++m) { const int r0 = u.pm * 256 + ai * 128 + wr * 64 + m * 16 + 4 * fq;
                if (r0 < T + NMETA) {
                    f32x4 rs;
#pragma unroll
                    for (int j = 0; j < 4; ++j) rs[j] = 1.0f / sqrtf(ssq_kv_of(ssqp, r0 + j) * (1.f / KVL) + RMS_EPS);
                    int b0, b1, key; if (r0 < T) { b0 = r0 >> 11; b1 = b0 + 1; key = NMETA + (r0 & 2047); } else { b0 = 0; b1 = NB; key = r0 - T; }
                    const int kp = keypos(key);
#pragma unroll
                    for (int bj = 0; bj < 2; ++bj)
#pragma unroll
                        for (int n = 0; n < 2; ++n) { const int cv = u.pn * 256 + bj * 128 + wc * 32 + 8 * (fr >> 2) + 4 * n + (fr & 3); const int h = cv >> 7, d = cv & 127;
                            const f32x4 v = acc[ai][bj][m][n] * rs; v2u o; o.x = pk2(v[0], v[1]); o.y = pk2(v[2], v[3]);
                            for (int b = b0; b < b1; ++b) *(v2u*)(Vt + (((size_t)b * NH + h) * DV + d) * KPAD + kp) = o; }
                }
            }
    }
};

constexpr int CT = 32, CROWS = CT + 30;
__device__ __forceinline__ void conv_unit(LAS unsigned char* lds, int unit, const bf16* proj, const float* dw_w, const float* dw_b, const float* ln_g, const float* ln_b, unsigned char* mix) {
    int tid = my_tid(); asm volatile("" : "+v"(tid));
    const int lane = tid & 63, wave = tid >> 6;
    const int b = unit / (S / CT), s0 = (unit % (S / CT)) * CT, p0 = s0 + NMETA;
    LAS unsigned char* glu = lds; LAS float* red = (LAS float*)(lds + CROWS * 2048);
#pragma unroll 4
    for (int idx = tid; idx < CROWS * 128; idx += NTHR) { const int row = idx >> 7, c8 = idx & 127; const int j = p0 - 30 + row;
        v4u o = {0u, 0u, 0u, 0u};
        if (j >= 0) { const int srow = (j < NMETA) ? (T + j) : (b * S + j - NMETA);
            const v4u a = *(const v4u*)(proj + (size_t)srow * NPROJP + PC_A + 8 * c8), g = *(const v4u*)(proj + (size_t)srow * NPROJP + PC_G + 8 * c8);
            const unsigned av[4] = {a.x, a.y, a.z, a.w}, gv[4] = {g.x, g.y, g.z, g.w}; unsigned ov[4];
#pragma unroll
            for (int p = 0; p < 4; ++p) { const float a0 = __uint_as_float(av[p] << 16), a1 = __uint_as_float(av[p] & 0xffff0000u), g0 = __uint_as_float(gv[p] << 16), g1 = __uint_as_float(gv[p] & 0xffff0000u);
                ov[p] = pk2(a0 * __builtin_amdgcn_rcpf(1.0f + __expf(-g0)), a1 * __builtin_amdgcn_rcpf(1.0f + __expf(-g1))); }
            o.x = ov[0]; o.y = ov[1]; o.z = ov[2]; o.w = ov[3]; }
        *(LAS v4u*)(glu + row * 2048 + c8 * 16) = o; }
    __syncthreads();
    float w0[CW], w1[CW];
#pragma unroll
    for (int w = 0; w < CW; ++w) { const float2 ww = *(const float2*)(dw_w + w * CC + 2 * tid); w0[w] = ww.x; w1[w] = ww.y; }
#pragma unroll
    for (int hf = 0; hf < CT / 16; ++hf) {
        float acc0[16], acc1[16];
        { const float2 bb = *(const float2*)(dw_b + 2 * tid);
#pragma unroll
          for (int t = 0; t < 16; ++t) { acc0[t] = bb.x; acc1[t] = bb.y; } }
        const LAS unsigned char* gl = glu + hf * 16 * 2048;
#pragma unroll
        for (int j = 0; j < 46; ++j) { if ((j & 7) == 0) __builtin_amdgcn_sched_barrier(0);
            const unsigned xv = *(const LAS unsigned*)(gl + j * 2048 + tid * 4); const float x0 = __uint_as_float(xv << 16), x1 = __uint_as_float(xv & 0xffff0000u);
#pragma unroll
            for (int t = 0; t < 16; ++t) { const int w = j - t; if (w >= 0 && w < CW) { acc0[t] += x0 * w0[w]; acc1[t] += x1 * w1[w]; } } }
#pragma unroll
        for (int t = 0; t < 16; ++t) { const float p = wave_sum(acc0[t] + acc1[t]); if (lane == 0) red[t * 8 + wave] = p; }
        __syncthreads();
#pragma unroll
        for (int t = 0; t < 16; ++t) { float sum = 0.f;
#pragma unroll
            for (int w = 0; w < 8; ++w) sum += red[t * 8 + w];
            const float mean = sum * (1.f / CC); acc0[t] -= mean; acc1[t] -= mean; }
#pragma unroll
        for (int t = 0; t < 16; ++t) { const float p = wave_sum(acc0[t] * acc0[t] + acc1[t] * acc1[t]); if (lane == 0) red[128 + t * 8 + wave] = p; }
        __syncthreads();
        const float2 gg = *(const float2*)(ln_g + 2 * tid), bb2 = *(const float2*)(ln_b + 2 * tid);
#pragma unroll
        for (int t = 0; t < 16; ++t) { float sum = 0.f;
#pragma unroll
            for (int w = 0; w < 8; ++w) sum += red[128 + t * 8 + w];
            const float rstd = 1.0f / sqrtf(sum * (1.f / CC) + LN_EPS);
            const float y0 = acc0[t] * rstd * gg.x + bb2.x, y1 = acc1[t] * rstd * gg.y + bb2.y;
            *(unsigned short*)(mix + (size_t)(b * S + s0 + 16 * hf + t) * D + CC + 2 * tid) = (unsigned short)__builtin_amdgcn_cvt_pk_fp8_f32(MIX_S * y0 * __builtin_amdgcn_rcpf(1.0f + __expf(-y0)), MIX_S * y1 * __builtin_amdgcn_rcpf(1.0f + __expf(-y1)), 0, false); }
        __syncthreads();
    }
}

constexpr int ATT_KB = 64 * DQK * 2, ATT_VB = DV * 64 * 2, ATT_VOFF = 2 * ATT_KB;
__device__ __forceinline__ void attn_block(LAS unsigned char* lds, const bf16* Q, const bf16* Kc, const bf16* Vt, unsigned char* mix, int b, int h, int qb) {
    int tid = my_tid(); asm volatile("" : "+v"(tid));
    const int lane = tid & 63, wave = __builtin_amdgcn_readfirstlane(tid >> 6), ql = lane & 15, g = lane >> 4;
    const int s = qb * 128 + wave * 16 + ql, pos = s + NMETA;
    const int pos_lo = qb * 128 + wave * 16 + NMETA, pos_hi = pos_lo + 15;
    bf16x8 qf[6];
    { const bf16* qp = Q + (((size_t)b * NH + h) * S + s) * DQK + 8 * g;
#pragma unroll
      for (int ks = 0; ks < 6; ++ks) qf[ks] = *(const bf16x8*)(qp + 32 * ks); }
    const unsigned char* kbase = (const unsigned char*)(Kc + ((size_t)b * NH + h) * KPAD * DQK);
    const unsigned char* vbase = (const unsigned char*)(Vt + ((size_t)b * NH + h) * DV * KPAD);
    const int nt = 2 * qb + 3;
    unsigned kl[3], vl[2], vg[2];
#pragma unroll
    for (int i = 0; i < 3; ++i) { const int id = tid + 512 * i, row = id / 24, ch = id - row * 24; kl[i] = row * 384 + (((ch & ~7) | ((ch ^ (row >> 1)) & 7)) << 4); }
#pragma unroll
    for (int i = 0; i < 2; ++i) { const int id = tid + 512 * i, d = id >> 3, ch = id & 7; vl[i] = d * 128 + (((ch ^ (d >> 1)) & 7) << 4); vg[i] = d * (KPAD * 2) + ch * 16; }
    v4u kr[3], vr[2];
#define ATT_LOAD(t) do { _Pragma("unroll") for (int i = 0; i < 3; ++i) kr[i] = *(const v4u*)(kbase + (size_t)(t) * ATT_KB + (size_t)(tid + 512 * i) * 16); \
                         _Pragma("unroll") for (int i = 0; i < 2; ++i) vr[i] = *(const v4u*)(vbase + (size_t)(t) * 128 + vg[i]); } while (0)
#define ATT_WRITE(buf) do { _Pragma("unroll") for (int i = 0; i < 3; ++i) *(LAS v4u*)(lds + (buf) * ATT_KB + kl[i]) = kr[i]; \
                            _Pragma("unroll") for (int i = 0; i < 2; ++i) *(LAS v4u*)(lds + ATT_VOFF + (buf) * ATT_VB + vl[i]) = vr[i]; } while (0)
    const int x = (ql >> 1) & 7;
    const unsigned kb0 = ql * 384 + ((g ^ x) << 4), kb1 = kb0 ^ 64u;
    const unsigned vb0 = ql * 128 + ((g ^ x) << 4), vb1 = vb0 ^ 64u;
    f32x4 o[8];
#pragma unroll
    for (int i = 0; i < 8; ++i) o[i] = (f32x4){0.f, 0.f, 0.f, 0.f};
    float m_run = -1e30f, l_run = 0.f;
    ATT_LOAD(0); ATT_WRITE(0);
    __syncthreads();
    for (int t = 0; t < nt; ++t) {
        const int buf = t & 1;
        if (t + 1 < nt) ATT_LOAD(t + 1);
        if (64 * t <= pos_hi) {
            const LAS unsigned char* kt = lds + buf * ATT_KB; const LAS unsigned char* vt = lds + ATT_VOFF + buf * ATT_VB;
            f32x4 sc[4];
#pragma unroll
            for (int kb = 0; kb < 4; ++kb) { sc[kb] = (f32x4){0.f, 0.f, 0.f, 0.f};
#pragma unroll
                for (int ks = 0; ks < 6; ++ks) { const bf16x8 kf = *(const LAS bf16x8*)(kt + ((ks & 1) ? kb1 : kb0) + kb * 6144 + (ks >> 1) * 128);
                    sc[kb] = __builtin_amdgcn_mfma_f32_16x16x32_bf16(kf, qf[ks], sc[kb], 0, 0, 0); } }
            bf16x8 vf[4][2];
#pragma unroll
            for (int db = 0; db < 4; ++db)
#pragma unroll
                for (int k2 = 0; k2 < 2; ++k2) vf[db][k2] = *(const LAS bf16x8*)(vt + (k2 ? vb1 : vb0) + db * 2048);
            if (64 * t + 63 > pos_lo) {
#pragma unroll
                for (int kb = 0; kb < 4; ++kb)
#pragma unroll
                    for (int r = 0; r < 4; ++r) if (64 * t + 16 * kb + 4 * g + r > pos) sc[kb][r] = -1e30f;
            }
            float mx = sc[0][0];
#pragma unroll
            for (int kb = 0; kb < 4; ++kb)
#pragma unroll
                for (int r = 0; r < 4; ++r) mx = fmaxf(mx, sc[kb][r]);
            mx = fmaxf(mx, __shfl_xor(mx, 16)); mx = fmaxf(mx, __shfl_xor(mx, 32));
            const float m_new = fmaxf(m_run, mx);
            const float alpha = __builtin_amdgcn_exp2f(m_run - m_new);
            m_run = m_new;
            float ps = 0.f;
#pragma unroll
            for (int kb = 0; kb < 4; ++kb)
#pragma unroll
                for (int r = 0; r < 4; ++r) { sc[kb][r] = __builtin_amdgcn_exp2f(sc[kb][r] - m_new); ps += sc[kb][r]; }
            l_run = l_run * alpha + ps;
#pragma unroll
            for (int i = 0; i < 8; ++i) o[i] = o[i] * alpha;
            union { v4u u; bf16x8 v; } pf[2];
#pragma unroll
            for (int k2 = 0; k2 < 2; ++k2) { pf[k2].u.x = pg8::cvt_pk_bf16(sc[2 * k2][0], sc[2 * k2][1]); pf[k2].u.y = pg8::cvt_pk_bf16(sc[2 * k2][2], sc[2 * k2][3]);
                pf[k2].u.z = pg8::cvt_pk_bf16(sc[2 * k2 + 1][0], sc[2 * k2 + 1][1]); pf[k2].u.w = pg8::cvt_pk_bf16(sc[2 * k2 + 1][2], sc[2 * k2 + 1][3]); }
#pragma unroll
            for (int db = 0; db < 8; ++db)
#pragma unroll
                for (int k2 = 0; k2 < 2; ++k2) { const bf16x8 vq = (db < 4) ? vf[db & 3][k2] : *(const LAS bf16x8*)(vt + (k2 ? vb1 : vb0) + db * 2048);
                    o[db] = __builtin_amdgcn_mfma_f32_16x16x32_bf16(vq, pf[k2].v, o[db], 0, 0, 0); }
        }
        if (t + 1 < nt) ATT_WRITE(buf ^ 1);
        __syncthreads();
    }
#undef ATT_LOAD
#undef ATT_WRITE
    float l = l_run; l += __shfl_xor(l, 16); l += __shfl_xor(l, 32);
    const float inv = MIX_S / l;
    unsigned char* op = mix + (size_t)(b * S + s) * D + h * DV + 4 * g;
#pragma unroll
    for (int db = 0; db < 8; ++db) { int w = __builtin_amdgcn_cvt_pk_fp8_f32(o[db][0] * inv, o[db][1] * inv, 0, false); w = __builtin_amdgcn_cvt_pk_fp8_f32(o[db][2] * inv, o[db][3] * inv, w, true);
        *(int*)(op + 16 * db) = w; }
}


struct EpiRes { static constexpr bool PERM = false, STAGED = false;
    float* x1; const float* x; const float* lnstat; const float* g; const float* b;
    __device__ __forceinline__ void operator()(const f32x4 (&acc)[2][2][4][2], const pg8::Unit& u, int wr, int wc, int fr, int fq) const {
        const int row0 = u.pm * 256 + wr * 64 + fr, col0 = u.pn * 256 + wc * 32 + 4 * fq;
#pragma unroll
        for (int ai = 0; ai < 2; ++ai)
#pragma unroll
            for (int m = 0; m < 4; ++m) { const int r = row0 + ai * 128 + m * 16; const size_t off = (size_t)r * D + col0;
                const float mean = lnstat[2 * r], rstd = lnstat[2 * r + 1];
#pragma unroll
                for (int bj = 0; bj < 2; ++bj)
#pragma unroll
                    for (int n = 0; n < 2; ++n) { const int c = col0 + bj * 128 + n * 16; const f32x4 xv = *(const f32x4*)(x + off + bj * 128 + n * 16), gg = *(const f32x4*)(g + c), bb = *(const f32x4*)(b + c);
                        const f32x4 hv = (xv - mean) * rstd * gg + bb; *(f32x4*)(x1 + off + bj * 128 + n * 16) = hv * ALPHA + acc[ai][bj][m][n] * (1.0f / (MIX_S * F8_SW)); } }
    }
};
struct EpiSwiglu { static constexpr bool PERM = true, STAGED = false;
    unsigned char* act; const float* b1;
    __device__ __forceinline__ void operator()(const f32x4 (&acc)[2][2][4][2], const pg8::Unit& u, int wr, int wc, int fr, int fq) const {
        const int e = u.pm >> 5, pnl = u.pn & 15; const int row0 = u.pm * 256 + wr * 64 + fr, col0 = 128 * pnl + wc * 32 + 8 * fq;
        const float* bg = b1 + (size_t)e * 4096 + col0; const float* bu = bg + 2048;
        const f32x4 bg0 = *(const f32x4*)bg, bg1 = *(const f32x4*)(bg + 4), bu0 = *(const f32x4*)bu, bu1 = *(const f32x4*)(bu + 4);
#pragma unroll
        for (int ai = 0; ai < 2; ++ai)
#pragma unroll
            for (int m = 0; m < 4; ++m) { float a[8];
#pragma unroll
                for (int n = 0; n < 2; ++n)
#pragma unroll
                    for (int j = 0; j < 4; ++j) { float gv = acc[ai][0][m][n][j] * F8_INV + (n ? bg1[j] : bg0[j]), uv = acc[ai][1][m][n][j] * F8_INV + (n ? bu1[j] : bu0[j]);
                        gv = fminf(gv, SW_LIMIT); uv = fminf(fmaxf(uv, -SW_LIMIT), SW_LIMIT);
                        a[4 * n + j] = (F8_SX * gv) * (uv + 1.0f) * __builtin_amdgcn_rcpf(1.0f + __builtin_amdgcn_exp2f(-SW_ALPHA * 1.4426950408889634f * gv)); }
                int w0 = __builtin_amdgcn_cvt_pk_fp8_f32(a[0], a[1], 0, false); w0 = __builtin_amdgcn_cvt_pk_fp8_f32(a[2], a[3], w0, true);
                int w1 = __builtin_amdgcn_cvt_pk_fp8_f32(a[4], a[5], 0, false); w1 = __builtin_amdgcn_cvt_pk_fp8_f32(a[6], a[7], w1, true);
                v2u o; o.x = (unsigned)w0; o.y = (unsigned)w1;
                *(v2u*)(act + (size_t)(row0 + ai * 128 + m * 16) * DFF + col0) = o; }
    }
};
constexpr int STG_OFF = 131072, STG_BIAS = 17408;
struct EpiEo { static constexpr bool PERM = true, STAGED = true;
    unsigned char* eo; const float* b2; LAS unsigned char* stg;
    __device__ __forceinline__ void pre(const pg8::Unit& u, int ui, int wid, int lane) const {
        if (wid == 0) { const int e = u.pm >> 5, pnl = u.pn & 7;
            __builtin_amdgcn_global_load_lds((const unsigned*)(b2 + (size_t)e * D + 256 * pnl + 4 * lane), (LAS unsigned*)(stg + STG_BIAS + (ui & 1) * 1024), 16, 0, 0); }
    }
    __device__ __forceinline__ void run(const f32x4 (&acc)[2][2][4][2], const pg8::Unit& u, int wr, int wc, int fr, int fq, int tid, int ui) const {
        const int pnl = u.pn & 7;
        const LAS float* bl = (const LAS float*)(stg + STG_BIAS + (ui & 1) * 1024) + wc * 32 + 8 * fq;
        f32x4 bv[2][2];
#pragma unroll
        for (int bj = 0; bj < 2; ++bj)
#pragma unroll
            for (int n = 0; n < 2; ++n) bv[bj][n] = *(const LAS f32x4*)(bl + 128 * bj + 4 * n);
        LAS unsigned char* wp = stg + (32 * wr + fr) * 264 + 32 * wc + 8 * fq;
#pragma unroll
        for (int ai = 0; ai < 2; ++ai)
#pragma unroll
            for (int mp = 0; mp < 2; ++mp) {
#pragma unroll
                for (int mm = 0; mm < 2; ++mm)
#pragma unroll
                    for (int bj = 0; bj < 2; ++bj) { const int m = 2 * mp + mm; const f32x4 v0 = acc[ai][bj][m][0] * F8_INV + bv[bj][0], v1 = acc[ai][bj][m][1] * F8_INV + bv[bj][1];
                        s16x2_t r0 = {0, 0}, r1 = {0, 0};
                        r0 = __builtin_amdgcn_cvt_scalef32_pk_fp8_f32(r0, v0[0], v0[1], 1.0f / F8_SE, false); r0 = __builtin_amdgcn_cvt_scalef32_pk_fp8_f32(r0, v0[2], v0[3], 1.0f / F8_SE, true);
                        r1 = __builtin_amdgcn_cvt_scalef32_pk_fp8_f32(r1, v1[0], v1[1], 1.0f / F8_SE, false); r1 = __builtin_amdgcn_cvt_scalef32_pk_fp8_f32(r1, v1[2], v1[3], 1.0f / F8_SE, true);
                        v2u o; o.x = __builtin_bit_cast(unsigned, r0); o.y = __builtin_bit_cast(unsigned, r1);
                        *(LAS v2u*)(wp + 16 * mm * 264 + 128 * bj) = o; }
                LDS_WAIT(); __builtin_amdgcn_s_barrier();
#pragma unroll
                for (int j = 0; j < 2; ++j) { const int p = tid + 512 * j, rl = p >> 4, c16 = p & 15;
                    const v2u lo = *(const LAS v2u*)(stg + rl * 264 + 16 * c16), hi = *(const LAS v2u*)(stg + rl * 264 + 16 * c16 + 8);
                    v4u o4; o4.x = lo.x; o4.y = lo.y; o4.z = hi.x; o4.w = hi.y;
                    const int grow = u.pm * 256 + 128 * ai + 64 * (rl >> 5) + 16 * (2 * mp + ((rl >> 4) & 1)) + (rl & 15);
                    *(v4u*)(eo + (size_t)grow * D + 256 * pnl + 16 * c16) = o4; }
                if (!(ai == 1 && mp == 1)) { LDS_WAIT(); __builtin_amdgcn_s_barrier(); }
            }
    }
};
struct MoeOrder {
    const LAS int* pre; int G, c, NT, ioff, icnt;
    __device__ bool next(int i, pg8::Unit& u) const {
        if (i >= icnt) return false;
        const int L = (i + ioff) * G + c; if (L >= pre[NE]) return false;
        int e = 0; while (pre[e + 1] <= L) ++e;
        const int idx = L - pre[e], te = (pre[e + 1] - pre[e]) / NT; const int pn = idx / te, mt = idx - pn * te;
        u.pm = e * (CAP / 256) + mt; u.pn = e * NT + pn; return true;
    }
};

constexpr int HS = 2052;
__device__ __forceinline__ void ln1_router_unit(LAS unsigned char* lds, int unit, const float* x1, const float* g1, const float* b1n, const float* wr_, const float* br_,
                                                bf16* h1b, unsigned char* xg, int* cnt, int* r_e, float* r_g, int* r_pos) {
    int tid = my_tid(); asm volatile("" : "+v"(tid));
    const int lane = tid & 63, wave = __builtin_amdgcn_readfirstlane(tid >> 6);
    LAS float* hbuf = (LAS float*)lds; LAS float* part = hbuf + 16 * HS; LAS float* logits = part + 8 * 512;
    LAS int* sel = (LAS int*)(logits + 512); LAS int* rank = sel + 64; LAS int* base = rank + 64;
#pragma unroll 1
    for (int rr = 0; rr < 2; ++rr) { const int rl = 2 * wave + rr; const size_t r = (size_t)unit * 16 + rl;
        f32x4 v[8]; float s = 0.f;
#pragma unroll
        for (int j = 0; j < 8; ++j) { v[j] = __builtin_nontemporal_load((const f32x4*)(x1 + r * D + 4 * lane + 256 * j)); s += (v[j][0] + v[j][1]) + (v[j][2] + v[j][3]); }
        const float mean = wave_sum(s) * (1.f / D); float s2 = 0.f;
#pragma unroll
        for (int j = 0; j < 8; ++j) { v[j] = v[j] - mean; s2 += (v[j][0] * v[j][0] + v[j][1] * v[j][1]) + (v[j][2] * v[j][2] + v[j][3] * v[j][3]); }
        const float rstd = 1.0f / sqrtf(wave_sum(s2) * (1.f / D) + LN_EPS);
#pragma unroll
        for (int j = 0; j < 8; ++j) { const int c = 4 * lane + 256 * j; const f32x4 gg = *(const f32x4*)(g1 + c), bb = *(const f32x4*)(b1n + c);
            const f32x4 y = v[j] * rstd * gg + bb; v2u hb; hb.x = pk2(y[0], y[1]); hb.y = pk2(y[2], y[3]); *(v2u*)(h1b + r * D + c) = hb; *(LAS f32x4*)(hbuf + rl * HS + c) = y; } }
    __syncthreads();
    { const int e15 = lane & 15, kq = lane >> 4; f32x4 a0 = {0.f, 0.f, 0.f, 0.f}, a1 = {0.f, 0.f, 0.f, 0.f};
      const LAS float* hp = hbuf + e15 * HS + 256 * wave + kq; const float* wp = wr_ + (size_t)(256 * wave + kq) * NE + e15;
#pragma unroll 8
      for (int ks = 0; ks < 64; ++ks) { const float av = hp[4 * ks]; const float w0 = wp[(size_t)ks * 4 * NE], w1 = wp[(size_t)ks * 4 * NE + 16];
          a0 = __builtin_amdgcn_mfma_f32_16x16x4f32(av, w0, a0, 0, 0, 0); a1 = __builtin_amdgcn_mfma_f32_16x16x4f32(av, w1, a1, 0, 0, 0); }
#pragma unroll
      for (int q = 0; q < 4; ++q) { part[wave * 512 + (4 * kq + q) * 32 + e15] = a0[q]; part[wave * 512 + (4 * kq + q) * 32 + 16 + e15] = a1[q]; } }
    __syncthreads();
    { float sum = br_[tid & 31];
#pragma unroll
      for (int w = 0; w < 8; ++w) sum += part[w * 512 + tid];
      logits[tid] = sum; }
    __syncthreads();
#pragma unroll 1
    for (int rr = 0; rr < 2; ++rr) { const int rl = 2 * wave + rr; const int r = unit * 16 + rl;
        float val = (lane < NE) ? logits[rl * 32 + (lane & 31)] : -3.0e38f;
        int te[4]; float tv[4];
#pragma unroll
        for (int k = 0; k < 4; ++k) { float m = val;
#pragma unroll
            for (int o = 1; o < 64; o <<= 1) m = fmaxf(m, __shfl_xor(m, o));
            const unsigned long long mask = __ballot(val == m && lane < NE);
            const int e = __ffsll((long long)mask) - 1;
            te[k] = e; tv[k] = m; if (lane == e) val = -3.0e38f; }
        float ex[4], se = 0.f;
#pragma unroll
        for (int k = 0; k < 4; ++k) { ex[k] = expf(tv[k] - tv[0]); se += ex[k]; }
        if (lane == 0) { const float ise = 1.0f / se;
#pragma unroll
            for (int k = 0; k < 4; ++k) { r_e[r * 4 + k] = te[k]; r_g[r * 4 + k] = ex[k] * ise; sel[rl * 4 + k] = te[k]; } } }
    __syncthreads();
    if (wave == 0) { int count = 0;
        for (int i = 0; i < 64; ++i) { const int s_ = sel[i]; if (s_ == lane) { rank[i] = count; ++count; } }
        int bse = 0; if (lane < NE && count > 0) bse = atomicAdd(&cnt[lane * 64], count);
        if (lane < NE) base[lane] = bse; }
    __syncthreads();
#pragma unroll 1
    for (int rr = 0; rr < 2; ++rr) { const int rl = 2 * wave + rr; const int r = unit * 16 + rl;
        int te[4], pos[4];
#pragma unroll
        for (int k = 0; k < 4; ++k) { te[k] = sel[rl * 4 + k]; pos[k] = base[te[k]] + rank[rl * 4 + k]; }
        if (lane == 0) {
#pragma unroll
            for (int k = 0; k < 4; ++k) r_pos[r * 4 + k] = pos[k]; }
#pragma unroll
        for (int j = 0; j < 2; ++j) { const int c = 16 * (lane + 64 * j); v4u o; unsigned ov[4];
#pragma unroll
            for (int q = 0; q < 4; ++q) { const f32x4 y = *(const LAS f32x4*)(hbuf + rl * HS + c + 4 * q) * F8_SX;
                int w = __builtin_amdgcn_cvt_pk_fp8_f32(y[0], y[1], 0, false); w = __builtin_amdgcn_cvt_pk_fp8_f32(y[2], y[3], w, true); ov[q] = (unsigned)w; }
            o.x = ov[0]; o.y = ov[1]; o.z = ov[2]; o.w = ov[3];
#pragma unroll
            for (int k = 0; k < 4; ++k) *(v4u*)(xg + ((size_t)te[k] * CAP + pos[k]) * D + c) = o; } }
    __syncthreads();
}

__device__ __forceinline__ void moe_prefix(LAS int* pre, const int* cnt, int NT, int elo, int ehi, int tid) {
    if (tid < 64) { int nt = 0;
        if (tid < NE && tid >= elo && tid < ehi) nt = ((__hip_atomic_load(&cnt[tid * 64], __ATOMIC_RELAXED, __HIP_MEMORY_SCOPE_AGENT) + 255) >> 8) * NT;
        int incl = nt;
#pragma unroll
        for (int o = 1; o < 32; o <<= 1) { const int t = __shfl_up(incl, o); if (tid >= o) incl += t; }
        if (tid < NE) pre[tid] = incl - nt;
        if (tid == NE - 1) pre[NE] = incl; }
}

__global__ void __launch_bounds__(NTHR, 2) mk_fwd(Args args) {
    LAS unsigned char* lds = (LAS unsigned char*)lds_raw;
    volatile LAS unsigned* MISC = (volatile LAS unsigned*)(lds + MISC_OFF);
    for (int u = threadIdx.x; u < (LDS_BYTES - MISC_OFF) / 4; u += NTHR) ((LAS unsigned*)(lds + MISC_OFF))[u] = 0u;
    __syncthreads();
    if ((threadIdx.x & 63) == 0) ((LAS int*)(lds + TIDTAB_OFF))[hw_slot()] = threadIdx.x >> 6;
    __syncthreads();
    const int wave = __builtin_amdgcn_readfirstlane(my_tid() >> 6);
    const int G = gridDim.x; const int bx = blockIdx.x; const int vcu = (G % 8 == 0) ? (bx % 8) * (G / 8) + bx / 8 : bx;
    unsigned char* ws = args.ws;
    unsigned* ctl = (unsigned*)(ws + WS_CTL);
    const int lo = args.ph_lo, hi = args.ph_hi;
    const bool multi = (hi - lo) > 1;
    XcdBarrier bar; bar.bar = ctl + CW_BAR; bar.x = 0; bar.st = nullptr;
    if (multi) bar = xcd_barrier_post(ctl + CW_BAR, MISC + 8);
#define IN(k) (lo <= (k) && (k) < hi)
#define SEAM(k) do { if (IN(k) && IN((k) + 1)) xcd_barrier(bar); } while (0)
    bf16* wt_uq = (bf16*)(ws + WS_WTUQ); bf16* wt_kv = (bf16*)(ws + WS_WTKV); bf16* wt_out = (bf16*)(ws + WS_WTOUT);
    unsigned char* h0b8 = ws + WS_H0B; unsigned char* wt_in8 = ws + WS_WTIN; float* rsc = (float*)(ws + WS_RSC); float* csc = (float*)(ws + WS_CSC); bf16* proj = (bf16*)(ws + WS_PROJ);
    float* rope = (float*)(ws + WS_ROPE);
    float* ssqp = (float*)(ws + WS_SSQP); float* lnstat = (float*)(ctl + CW_LNSTAT);
    const int gw = vcu * NWAVES + wave, NGW = G * NWAVES;
    const int cvA = (G == 256) ? CONV_P1 : 0, cvB = cvA + CONV_P3_PER_WAVE * NGW, cvC = cvB + CONV_P2_PER_WAVE * NGW, cvD = cvC + CONV_P4_PER_WAVE * NGW, cvE = cvD + CONV_P5_PER_WAVE * NGW;
#define HOST_CONV(lo, hi) do { __syncthreads(); conv_items((lo) + gw, (hi), NGW, args.in[19], args.in[21], ws + WS_WT1, ws + WS_WT2, lds + wave * 16384, my_lane()); __syncthreads(); } while (0)
    const unsigned hslot = (((unsigned)vcu * 2654435761u) >> 11);

    if (IN(0)) {
        const int lane = my_lane(), tid = wave * 64 + lane;
        LAS float* scr = (LAS float*)(lds + wave * 16384);
        constexpr int F_UQ = 32 * (QL / 128), F_KV = 64 * (KVL / 128), F_OUT = 64 * (D / 128), NFAST = F_UQ + F_KV + F_OUT;
        constexpr int S_UQ = 16 * (QL / 64), NSLOW = S_UQ;
        LAS unsigned char* dtile = lds + wave * 16384;
        for (int nbk = vcu; nbk < NPROJP / 32; nbk += G) wtin_block(lds, nbk, args.in[4], wt_in8, csc, tid);
        const int gw2 = (G > NPROJP / 32) ? ((vcu + G - NPROJP / 32) % G) * NWAVES + wave : gw;
        for (int it = gw2; it < NFAST + NSLOW; it += NGW) {
            int r = it;
            if (r < F_UQ) { const int nbq = r % 32, kb = r / 32; const int col = (nbq >> 2) * DQK + 32 * (nbq & 3); tb16_item(args.in[6], 1536, QL, wt_uq, col, col, 128 * kb, args.in[5], dtile, lane); continue; } r -= F_UQ;
            if (r < F_KV) { const int nb = r % 64, kb = r / 64;
                if (nb < 32) tb16_item(args.in[8], 1024, KVL, wt_kv, 32 * nb, 32 * nb, 128 * kb, args.in[7], dtile, lane);
                else tb16_item(args.in[9], 1024, KVL, wt_kv + (size_t)1024 * KVL, 32 * (nb - 32), 32 * (nb - 32), 128 * kb, args.in[7], dtile, lane);
                continue; } r -= F_KV;
            if (r < F_OUT) { const int nb = r % 64, kb = r / 64;
                TI64 t; t.ldw = D; t.K = D; t.src = args.in[14] + (size_t)(128 * kb + (lane >> 3)) * D + 32 * nb + 4 * (lane & 7); t.dst = (unsigned char*)wt_out + (size_t)(32 * nb) * D + 128 * kb;
                f32x4 v[16]; ti64_load(t, v); ti64_store(t, v, dtile, lane); continue; } r -= F_OUT;
            { const int j = r & 15, kb = r >> 4; const int n0 = (j >> 1) * DQK + 128 + 32 * (j & 1); transpose_item(args.in[6], 1536, QL, wt_uq, n0, 64 * kb, SC_uq{}, args.in[5], scr, lane); }
        }
        {
            unsigned char* wt1 = ws + WS_WT1; unsigned char* wt2 = ws + WS_WT2;
            constexpr int NIT = NE * ((D / 128) * (4096 / 32) + (DFF / 128) * (D / 32));
            LAS unsigned char* tile = lds + wave * 16384;
            conv_items(cvE + gw2, CONV_W2, NGW, args.in[19], args.in[21], wt1, wt2, tile, lane);
        }
        for (int r = gw; r < MROWS; r += NGW) {
            if (r < T) ln_row8(args.in[0] + (size_t)r * D, args.in[2], args.in[3], lnstat + 2 * r, h0b8 + (size_t)r * D, rsc + r, lane);
            else if (r < T + NMETA) ln_row8(args.in[1] + (size_t)(r - T) * D, args.in[2], args.in[3], nullptr, h0b8 + (size_t)r * D, rsc + r, lane);
            else { if (lane == 0) rsc[r] = 0.f;
#pragma unroll
                for (int j = 0; j < 8; ++j) *(unsigned*)(h0b8 + (size_t)r * D + 4 * lane + 256 * j) = 0u; }
        }
        for (int idx = (bx * NTHR + tid); idx < LSEQ * 32; idx += G * NTHR) {
            const int pos = idx / 32, i = idx % 32;
            const float inv = 1.0f / powf(10000.0f, (float)(2 * i) / 64.0f);
            const float f = (float)pos * inv;
            rope[2 * idx] = (float)cos((double)f); rope[2 * idx + 1] = (float)sin((double)f);
        }
    }
    SEAM(0);
    if (IN(1)) {
        pg8::Gemm g{(const bf16*)h0b8, (const bf16*)wt_in8, D / 2, D / 2, D / 2}; pg8::StaticOrder S; S.init(MROWS / 256, NPROJP / 256, G, bx);
        EpiProj E{proj, ssqp, rsc, csc};
        pg8::gemm_phase<EpiProj, pg8::StaticOrder, true, true, false, false, true>(lds, g, S, E);
        if (G == 256 && bx >= 206) {
            __syncthreads();
            conv_items((bx - 206) * NWAVES + wave, CONV_P1, 50 * NWAVES, args.in[19], args.in[21], ws + WS_WT1, ws + WS_WT2, lds + wave * 16384, my_lane());
        }
    }
    SEAM(1);
    if (IN(2)) {
        bf16* Q = (bf16*)(ws + WS_Q); bf16* Kc = (bf16*)(ws + WS_K); bf16* Vt = (bf16*)(ws + WS_V); unsigned char* mix = ws + WS_MIX;
        const unsigned s2 = hslot % 4u;
        if (s2 == 0) HOST_CONV(cvB, cvC);
        { pg8::Gemm g{proj + PC_Q, wt_uq, QL, NPROJP, QL}; pg8::StaticOrder S; S.init(T / 256, 1536 / 256, G, bx);
          EpiQ E{Q, ssqp, rope};
          pg8::gemm_phase<EpiQ, pg8::StaticOrder, true, true>(lds, g, S, E); }
        if (s2 == 1) HOST_CONV(cvB, cvC);
        { pg8::Gemm g{proj + PC_KV, wt_kv, KVL, NPROJP, KVL}; pg8::StaticOrder S; S.init(MROWS / 256, 1024 / 256, G, G == 256 ? (bx + 64) % G : bx);
          EpiKV E{Kc, Vt, ssqp, proj, rope};
          pg8::gemm_phase<EpiKV, pg8::StaticOrder, true, true>(lds, g, S, E); }
        if (s2 == 2) HOST_CONV(cvB, cvC);
        { pg8::Gemm g{proj + PC_KV, wt_kv + (size_t)1024 * KVL, KVL, NPROJP, KVL}; pg8::StaticOrder S; S.init(MROWS / 256, 1024 / 256, G, G == 256 ? (bx >= 192 ? bx - 192 : ((bx >= 68 && bx < 136) ? bx - 4 : 100000)) : G - 1 - bx);
          EpiVt E{Vt, ssqp};
          pg8::gemm_phase<EpiVt, pg8::StaticOrder, true, true, false, true>(lds, g, S, E); }
        if (s2 == 3) HOST_CONV(cvB, cvC);
        __syncthreads();
        for (int u = bx; u < T / CT; u += G) conv_unit(lds, u, proj, args.in[10], args.in[11], args.in[12], args.in[13], mix);
    }
    SEAM(2);
    if (IN(3)) {
        const bf16* Q = (const bf16*)(ws + WS_Q); const bf16* Kc = (const bf16*)(ws + WS_K); const bf16* Vt = (const bf16*)(ws + WS_V); unsigned char* mix = ws + WS_MIX;
        for (int pi = vcu; pi < NB * NH * 8; pi += G) { const int bh = pi >> 3, p = pi & 7;
            const int slot8 = (int)((((unsigned)vcu * 2654435761u) >> 13) % 8u); const int slot = slot8 < 3 ? 0 : (slot8 < 6 ? 1 : 2);
#define ATT_CONV() do { __syncthreads(); conv_items(cvA + gw, cvB, NGW, args.in[19], args.in[21], ws + WS_WT1, ws + WS_WT2, lds + wave * 16384, my_lane()); __syncthreads(); } while (0)
            if (slot == 0) ATT_CONV();
            attn_block(lds, Q, Kc, Vt, mix, bh >> 3, bh & 7, 15 - p);
            if (slot == 1) ATT_CONV();
            attn_block(lds, Q, Kc, Vt, mix, bh >> 3, bh & 7, p);
            if (slot == 2) ATT_CONV();
#undef ATT_CONV
        }
        if (vcu >= NB * NH * 8) { __syncthreads(); conv_items(cvA + gw, cvB, NGW, args.in[19], args.in[21], ws + WS_WT1, ws + WS_WT2, lds + wave * 16384, my_lane()); }
    }
    SEAM(3);
    if (IN(4)) {
        pg8::Gemm g{(const bf16*)(ws + WS_MIX), wt_out, D / 2, D / 2, D / 2}; pg8::StaticOrder S; S.init(T / 256, D / 256, G, bx);
        EpiRes E{(float*)(ws + WS_X1), args.in[0], lnstat, args.in[2], args.in[3]};
        if ((hslot & 1u) == 0u) HOST_CONV(cvC, cvD);
        pg8::gemm_phase<EpiRes, pg8::StaticOrder, true, true, true>(lds, g, S, E);
        if ((hslot & 1u) == 1u) HOST_CONV(cvC, cvD);
    }
    SEAM(4);
    int* cnt = (int*)(ctl + CW_CNT);
    int* r_e = (int*)(ws + WS_ROUTE); float* r_g = (float*)(ws + WS_ROUTE + 256 * 1024); int* r_pos = (int*)(ws + WS_ROUTE + 512 * 1024);
    bf16* h1b = (bf16*)(ws + WS_H1B); unsigned char* xg = ws + WS_XG; unsigned char* act = ws + WS_ACT; unsigned char* eo = ws + WS_EO;
    if (IN(5)) {
        const unsigned s5 = hslot % 3u; int ui5 = 0;
        if (s5 == 0) HOST_CONV(cvD, cvE);
        for (int u = bx; u < T / 16; u += G) { ln1_router_unit(lds, u, (const float*)(ws + WS_X1), args.in[15], args.in[16], args.in[17], args.in[18], h1b, xg, cnt, r_e, r_g, r_pos);
            if (++ui5 == 1 && s5 == 1) HOST_CONV(cvD, cvE); }
        if (s5 == 2 || (s5 == 1 && ui5 == 0)) HOST_CONV(cvD, cvE);
    }
    SEAM(5);
    LAS int* pre = (LAS int*)(lds + MISC_OFF + 256);
#define MOE1_STAGE(elo, ehi, cfirst, cend) do { \
        __syncthreads(); \
        moe_prefix(pre, cnt, 16, (elo), (ehi), wave * 64 + my_lane()); \
        __syncthreads(); \
        const int nun = pre[NE]; const int mine = (nun > vcu) ? (nun - vcu + G - 1) / G : 0; \
        const int kbrk = (int)((((unsigned)vcu * 2654435761u) >> 16) % (unsigned)(mine + 1)); \
        pg8::Gemm g{(const bf16*)xg, (const bf16*)(ws + WS_WT1), D / 2, D / 2, D / 2}; EpiSwiglu E{act, args.in[20]}; \
        { MoeOrder S{pre, G, vcu, 16, 0, kbrk}; pg8::gemm_phase<EpiSwiglu, MoeOrder, true, true, true>(lds, g, S, E); } \
        __syncthreads(); \
        conv_items((cfirst) + gw, (cend), NGW, args.in[19], args.in[21], ws + WS_WT1, ws + WS_WT2, lds + wave * 16384, my_lane()); \
        __syncthreads(); \
        { MoeOrder S{pre, G, vcu, 16, kbrk, mine - kbrk}; pg8::gemm_phase<EpiSwiglu, MoeOrder, true, true, true>(lds, g, S, E); } \
    } while (0)
    if (IN(6)) MOE1_STAGE(0, NE, CONV_W2, CONV_END);
    SEAM(6);
#undef MOE1_STAGE
    if (IN(7)) {
        __syncthreads();
        moe_prefix(pre, cnt, 8, 0, NE, wave * 64 + my_lane());
        __syncthreads();
        pg8::Gemm g{(const bf16*)act, (const bf16*)(ws + WS_WT2), DFF / 2, DFF / 2, DFF / 2}; MoeOrder S{pre, G, vcu, 8, 0, 1 << 30};
        EpiEo E{eo, args.in[22], lds + STG_OFF};
        pg8::gemm_phase<EpiEo, MoeOrder, true, true, true>(lds, g, S, E);
    }
    SEAM(7);
    if (IN(8)) {
        const int lane = my_lane();
        for (int r = gw; r < T; r += NGW) {
            f32x4 v[8];
#pragma unroll
            for (int j = 0; j < 8; ++j) { const v2u x = __builtin_nontemporal_load((const v2u*)(h1b + (size_t)r * D + 4 * lane + 256 * j));
                v[j][0] = ALPHA * __uint_as_float(x.x << 16); v[j][1] = ALPHA * __uint_as_float(x.x & 0xffff0000u); v[j][2] = ALPHA * __uint_as_float(x.y << 16); v[j][3] = ALPHA * __uint_as_float(x.y & 0xffff0000u); }
#pragma unroll
            for (int k = 0; k < 4; ++k) { const float gk = r_g[r * 4 + k] * (1.0f / F8_SE); const unsigned char* src = eo + ((size_t)r_e[r * 4 + k] * CAP + r_pos[r * 4 + k]) * D;
#pragma unroll
                for (int j = 0; j < 8; ++j) { const int x = __builtin_nontemporal_load((const int*)(src + 4 * lane + 256 * j));
                    const pg8::f32x2v lo = __builtin_amdgcn_cvt_pk_f32_fp8(x, false), hi = __builtin_amdgcn_cvt_pk_f32_fp8(x, true);
                    v[j][0] += gk * lo[0]; v[j][1] += gk * lo[1]; v[j][2] += gk * hi[0]; v[j][3] += gk * hi[1]; } }
            float s_ = 0.f;
#pragma unroll
            for (int j = 0; j < 8; ++j) s_ += (v[j][0] + v[j][1]) + (v[j][2] + v[j][3]);
            const float mean = wave_sum(s_) * (1.f / D); float s2 = 0.f;
#pragma unroll
            for (int j = 0; j < 8; ++j) { v[j] = v[j] - mean; s2 += (v[j][0] * v[j][0] + v[j][1] * v[j][1]) + (v[j][2] * v[j][2] + v[j][3] * v[j][3]); }
            const float rstd = 1.0f / sqrtf(wave_sum(s2) * (1.f / D) + LN_EPS);
#pragma unroll
            for (int j = 0; j < 8; ++j) { const int c = 4 * lane + 256 * j; const f32x4 gg = *(const f32x4*)(args.in[23] + c), bb = *(const f32x4*)(args.in[24] + c);
                *(f32x4*)(args.out + (size_t)r * D + c) = v[j] * rstd * gg + bb; }
        }
    }
#undef HOST_CONV
#undef IN
#undef SEAM
}

static int mk_grid = 0;
static void mk_launch(Args a, int lo, int hi, hipStream_t stream) {
    if (mk_grid == 0) {
        int dev = 0, cus = 0;
        (void)hipGetDevice(&dev); (void)hipDeviceGetAttribute(&cus, hipDeviceAttributeMultiprocessorCount, dev);
        if (hipFuncSetAttribute((const void*)mk_fwd, hipFuncAttributeMaxDynamicSharedMemorySize, LDS_BYTES) != hipSuccess) fprintf(stderr, "hipFuncSetAttribute failed\n");
        int per_cu = 0; (void)hipOccupancyMaxActiveBlocksPerMultiprocessor(&per_cu, (const void*)mk_fwd, NTHR, LDS_BYTES);
        if (per_cu < 1) fprintf(stderr, "occupancy query says %d\n", per_cu);
        (void)hipGetLastError();
        mk_grid = cus > 0 ? cus : 256;
    }
    a.ph_lo = lo; a.ph_hi = hi;
    hipLaunchKernelGGL(mk_fwd, dim3(mk_grid), dim3(NTHR), LDS_BYTES, stream, a);
}

extern "C" void kernel_launch(void* const* d_in, const int* in_sizes, int n_in, void* d_out, int out_size, void* d_ws, size_t ws_size, hipStream_t stream) {
    if (n_in != 25 || ws_size < WS_END) { fprintf(stderr, "kernel_launch: unexpected n_in %d or ws %zu\n", n_in, ws_size); return; }
    unsigned char* ws = (unsigned char*)d_ws;
    (void)hipMemsetAsync(ws + WS_CTL, 0, CTL_BYTES, stream);
    Args a{}; for (int i = 0; i < 25; ++i) a.in[i] = (const float*)d_in[i]; a.out = (float*)d_out; a.ws = ws;
    mk_launch(a, 0, 9, stream);
}
```
